# Optimizing an MI355X kernel written in HIP

```python
import jax, jax.numpy as jnp
from jax import lax
import numpy as np

D_MODEL = 1024
BATCH = 32
SEQ = 2048
DEPTH = 2

D_MIX = D_MODEL
GLA_HEADS = 4
GLA_HEAD_K = D_MIX // 16
GLA_HEAD_V = D_MIX // 8
GLA_GATE_RANK = 16
GLA_GATE_NORMALIZER = 16.0
HGRN_HEADS = 4
HGRN_HEAD_F = D_MIX // 16
HGRN_HEAD_I = D_MIX // 16
CONV_CHANNELS = D_MIX // 4
CONV_WIDTH = 3
CHUNK = 64
N_EXPERTS = 32
TOP_K = 4
D_FF = D_MODEL
SWIGLU_LIMIT = 7.0
SWIGLU_ALPHA = 1.702
MOE_BLOCK = 128
LN_EPS = 1e-5
RMS_EPS = 1e-6
DEEPNORM_ALPHA = (2 * DEPTH) ** 0.25
DEEPNORM_BETA = (8 * DEPTH) ** -0.25

GLA_K_DIM = GLA_HEADS * GLA_HEAD_K
GLA_V_DIM = GLA_HEADS * GLA_HEAD_V
HGRN_F_DIM = HGRN_HEADS * HGRN_HEAD_F
HGRN_I_DIM = HGRN_HEADS * HGRN_HEAD_I
IN_SPLITS = (GLA_K_DIM, GLA_K_DIM, GLA_V_DIM, GLA_GATE_RANK, GLA_V_DIM,
             HGRN_F_DIM, HGRN_F_DIM, HGRN_I_DIM, HGRN_I_DIM,
             CONV_CHANNELS, CONV_CHANNELS, CONV_CHANNELS)
D_IN_PROJ = sum(IN_SPLITS)

kernel_name = "hybrid_gla_hgrn2_shortconv_moe_deepnorm"


def layer_norm(x, g, b):
    xf = x.astype(jnp.float32)
    mu = jnp.mean(xf, axis=-1, keepdims=True)
    var = jnp.mean(jnp.square(xf - mu), axis=-1, keepdims=True)
    y = (xf - mu) * lax.rsqrt(var + LN_EPS) * g.astype(jnp.float32) + b.astype(jnp.float32)
    return y.astype(x.dtype)


def gated_head_rmsnorm(o, gate, g):
    bsz, t, h, dv = o.shape
    of = o.astype(jnp.float32)
    of = of * lax.rsqrt(jnp.mean(of * of, axis=-1, keepdims=True) + RMS_EPS) * g.astype(jnp.float32)
    return (of.reshape(bsz, t, h * dv) * jax.nn.silu(gate.astype(jnp.float32))).astype(gate.dtype)


def chunk_gated_linear_attention(q, k, v, log_a):
    bsz, t, h, dk = q.shape
    dv = v.shape[-1]
    n_chunks = t // CHUNK

    def to_chunks(z):
        return z.astype(jnp.float32).reshape(bsz, n_chunks, CHUNK, h, z.shape[-1]).transpose(1, 0, 3, 2, 4)

    causal = jnp.tril(jnp.ones((CHUNK, CHUNK), dtype=bool))[:, :, None]

    def step(state, blk):
        qb, kb, vb, gb = blk
        g_cum = jnp.cumsum(gb, axis=2)
        rel = g_cum[:, :, :, None, :] - g_cum[:, :, None, :, :]
        decay = jnp.where(causal, jnp.exp(jnp.minimum(rel, 0.0)), 0.0)
        scores = jnp.einsum("bhid,bhjd,bhijd->bhij", qb, kb, decay)
        o_intra = jnp.einsum("bhij,bhjv->bhiv", scores, vb)
        o_inter = jnp.einsum("bhid,bhdv->bhiv", qb * jnp.exp(g_cum), state)
        g_last = g_cum[:, :, -1:, :]
        new_state = (jnp.exp(g_last[:, :, 0, :, None]) * state
                     + jnp.einsum("bhjd,bhjv->bhdv", kb * jnp.exp(g_last - g_cum), vb))
        return new_state, o_intra + o_inter

    state0 = jnp.zeros((bsz, h, dk, dv), jnp.float32)
    _, o = lax.scan(step, state0, (to_chunks(q), to_chunks(k), to_chunks(v), to_chunks(log_a)))
    return o.transpose(1, 0, 3, 2, 4).reshape(bsz, t, h, dv).astype(v.dtype)


def hybrid_mixer(h, w_in, w_gla_gate_expand, b_gla_gate, gla_norm_g, lower_bound, hgrn_norm_g, conv_w, w_out):
    bsz, t, _ = h.shape
    proj = jnp.einsum("btd,de->bte", h, w_in)
    split_idx = np.cumsum(IN_SPLITS)[:-1].tolist()
    (gla_q, gla_k, gla_v, gla_lr, gla_og,
     hg_q, hg_f, hg_i, hg_og,
     cv_b, cv_c, cv_h) = jnp.split(proj, split_idx, axis=-1)

    q = gla_q.reshape(bsz, t, GLA_HEADS, GLA_HEAD_K) * (GLA_HEAD_K ** -0.5)
    k = gla_k.reshape(bsz, t, GLA_HEADS, GLA_HEAD_K)
    v = gla_v.reshape(bsz, t, GLA_HEADS, GLA_HEAD_V)
    gate_logits = jnp.einsum("btr,rk->btk", gla_lr, w_gla_gate_expand) + b_gla_gate
    log_a = (jax.nn.log_sigmoid(gate_logits.astype(jnp.float32)) / GLA_GATE_NORMALIZER)
    o_gla = chunk_gated_linear_attention(q, k, v, log_a.reshape(bsz, t, GLA_HEADS, GLA_HEAD_K))
    y_gla = gated_head_rmsnorm(o_gla, gla_og, gla_norm_g)

    z = hg_f.astype(jnp.float32)
    lb = lower_bound.astype(jnp.float32)
    f = lb + (1.0 - lb) * jax.nn.sigmoid(z)
    log_f = jnp.log(f)
    k_h = 1.0 - f
    q_h = jax.nn.silu(hg_q)
    o_h = chunk_gated_linear_attention(
        q_h.reshape(bsz, t, HGRN_HEADS, HGRN_HEAD_F),
        k_h.reshape(bsz, t, HGRN_HEADS, HGRN_HEAD_F),
        hg_i.reshape(bsz, t, HGRN_HEADS, HGRN_HEAD_I),
        log_f.reshape(bsz, t, HGRN_HEADS, HGRN_HEAD_F))
    y_hgrn = gated_head_rmsnorm(o_h, hg_og, hgrn_norm_g)

    u = cv_c * cv_h
    u_pad = jnp.pad(u, ((0, 0), (CONV_WIDTH - 1, 0), (0, 0)))
    conv = sum(conv_w[j] * u_pad[:, j:j + t, :] for j in range(CONV_WIDTH))
    y_conv = cv_b * conv

    y = jnp.concatenate([y_gla, y_hgrn, y_conv.astype(y_gla.dtype)], axis=-1)
    return jnp.einsum("bte,ed->btd", y, w_out)


def moe_sequence(xs, w_router, b_router, w_gate_up, b_gate_up, w_down, b_down):
    s = xs.shape[0]
    logits = jnp.einsum("sd,de->se", xs.astype(jnp.float32), w_router.astype(jnp.float32)) + b_router.astype(jnp.float32)
    top_logits, top_idx = lax.top_k(logits, TOP_K)
    gates = jax.nn.softmax(top_logits, axis=-1)
    m = s * TOP_K
    n_pad = m + N_EXPERTS * MOE_BLOCK
    n_blocks = n_pad // MOE_BLOCK
    expert_flat = top_idx.reshape(m)
    token_flat = jnp.arange(m, dtype=jnp.int32) // TOP_K
    order = jnp.argsort(expert_flat)
    expert_sorted = expert_flat[order]
    counts = jnp.zeros((N_EXPERTS,), jnp.int32).at[expert_flat].add(1)
    padded = (counts + MOE_BLOCK - 1) // MOE_BLOCK * MOE_BLOCK
    starts = jnp.cumsum(counts) - counts
    padded_ends = jnp.cumsum(padded)
    padded_starts = padded_ends - padded
    dest = padded_starts[expert_sorted] + jnp.arange(m, dtype=jnp.int32) - starts[expert_sorted]
    slot_token = jnp.zeros((n_pad,), jnp.int32).at[dest].set(token_flat[order])
    slot_gate = jnp.zeros((n_pad,), jnp.float32).at[dest].set(gates.reshape(m)[order])
    block_expert = jnp.minimum(
        jnp.searchsorted(padded_ends, jnp.arange(n_blocks, dtype=jnp.int32) * MOE_BLOCK, side="right"),
        N_EXPERTS - 1)
    x_slots = xs[slot_token].reshape(n_blocks, MOE_BLOCK, xs.shape[-1])

    def expert_block(args):
        xb, e = args
        gu = xb @ w_gate_up[e] + b_gate_up[e]
        gate, up = jnp.split(gu, 2, axis=-1)
        gate = jnp.minimum(gate, SWIGLU_LIMIT)
        up = jnp.clip(up, -SWIGLU_LIMIT, SWIGLU_LIMIT)
        act = (up + 1.0) * gate * jax.nn.sigmoid(SWIGLU_ALPHA * gate)
        return act @ w_down[e] + b_down[e]

    y_slots = lax.map(expert_block, (x_slots, block_expert)).reshape(n_pad, xs.shape[-1])
    weighted = y_slots * slot_gate[:, None].astype(y_slots.dtype)
    return jax.ops.segment_sum(weighted, slot_token, num_segments=s)


def setup_inputs(seed: int = 0) -> dict:
    key = jax.random.key(seed)
    ks = jax.random.split(key, 24)

    def nrm(k, shape, scale):
        return jax.random.normal(k, shape, jnp.float32) * scale

    L = DEPTH
    return {
        "x": nrm(ks[0], (BATCH, SEQ, D_MODEL), 1.0),
        "ln_in_g": 1.0 + nrm(ks[1], (D_MODEL,), 0.02),
        "ln_in_b": nrm(ks[2], (D_MODEL,), 0.02),
        "w_in": nrm(ks[3], (L, D_MODEL, D_IN_PROJ), D_MODEL ** -0.5),
        "w_gla_gate_expand": nrm(ks[4], (L, GLA_GATE_RANK, GLA_K_DIM), GLA_GATE_RANK ** -0.5),
        "b_gla_gate": nrm(ks[5], (L, GLA_K_DIM), 0.1),
        "gla_norm_g": 1.0 + nrm(ks[6], (L, GLA_HEAD_V), 0.02),
        "hgrn_lb_raw": nrm(ks[7], (L, HGRN_F_DIM), 0.5),
        "hgrn_norm_g": 1.0 + nrm(ks[8], (L, HGRN_HEAD_I), 0.02),
        "conv_w": nrm(ks[9], (L, CONV_WIDTH, CONV_CHANNELS), CONV_WIDTH ** -0.5),
        "w_out": nrm(ks[10], (L, D_MIX, D_MODEL), DEEPNORM_BETA * D_MIX ** -0.5),
        "ln_mix_g": 1.0 + nrm(ks[11], (L, D_MODEL), 0.02),
        "ln_mix_b": nrm(ks[12], (L, D_MODEL), 0.02),
        "w_router": nrm(ks[13], (L, D_MODEL, N_EXPERTS), D_MODEL ** -0.5),
        "b_router": nrm(ks[14], (L, N_EXPERTS), 0.01),
        "w_gate_up": nrm(ks[15], (L, N_EXPERTS, D_MODEL, 2 * D_FF), D_MODEL ** -0.5),
        "b_gate_up": nrm(ks[16], (L, N_EXPERTS, 2 * D_FF), 0.01),
        "w_down": nrm(ks[17], (L, N_EXPERTS, D_FF, D_MODEL), DEEPNORM_BETA * D_FF ** -0.5),
        "b_down": nrm(ks[18], (L, N_EXPERTS, D_MODEL), 0.01),
        "ln_ffn_g": 1.0 + nrm(ks[19], (L, D_MODEL), 0.02),
        "ln_ffn_b": nrm(ks[20], (L, D_MODEL), 0.02),
    }


def reference(x, ln_in_g, ln_in_b, w_in, w_gla_gate_expand, b_gla_gate, gla_norm_g, hgrn_lb_raw,
              hgrn_norm_g, conv_w, w_out, ln_mix_g, ln_mix_b, w_router, b_router, w_gate_up,
              b_gate_up, w_down, b_down, ln_ffn_g, ln_ffn_b):
    lb_p = jax.nn.softmax(hgrn_lb_raw.astype(jnp.float32), axis=0)
    lower_bounds = jnp.cumsum(lb_p, axis=0) - lb_p[0]

    h = layer_norm(x, ln_in_g, ln_in_b)
    for l in range(DEPTH):
        mix = hybrid_mixer(h, w_in[l], w_gla_gate_expand[l], b_gla_gate[l], gla_norm_g[l],
                           lower_bounds[l], hgrn_norm_g[l], conv_w[l], w_out[l])
        h = layer_norm(DEEPNORM_ALPHA * h + mix, ln_mix_g[l], ln_mix_b[l])
        ffn = lax.map(lambda xs: moe_sequence(xs, w_router[l], b_router[l], w_gate_up[l],
                                               b_gate_up[l], w_down[l], b_down[l]), h)
        h = layer_norm(DEEPNORM_ALPHA * h + ffn.astype(h.dtype), ln_ffn_g[l], ln_ffn_b[l])
    return h
```

```cpp
#include <hip/hip_runtime.h>
#include <cstdio>
#include <cstdint>

#ifndef MK_ONE_LAUNCH
#define MK_ONE_LAUNCH 0
#endif

namespace pg8 {
#define PG8_LAS __attribute__((address_space(3)))
typedef unsigned short bf16_t;
typedef short bf16x8 __attribute__((ext_vector_type(8)));
typedef float f32x4 __attribute__((ext_vector_type(4)));
typedef unsigned u32x4 __attribute__((ext_vector_type(4)));
constexpr int BM = 256, BK = 64, HALF = 128, HTB = HALF * BK * 2, STAGE_BYTES = 8 * HTB, NXCD = 8, WGM = 8;

__host__ __device__ __forceinline__ int lds_byte(int r, int c) { const int st = (r >> 4) * 2 + (c >> 5), rr = r & 15, cc = c & 31, ob = rr * 64 + cc * 2; return st * 1024 + (ob ^ (((ob >> 9) & 1) << 5)); }
__host__ __device__ __forceinline__ void stage_rc(int b, int& R, int& C) { const int st = b / 1024, sb = b % 1024, swz = sb ^ (((sb >> 9) & 1) << 5); R = (st >> 1) * 16 + swz / 64; C = (st & 1) * 32 + (swz % 64) / 2; }
__host__ __device__ __forceinline__ int perm32(int rho) { const int n = rho >> 4, i = rho & 15; return 8 * (i >> 2) + 4 * n + (i & 3); }

struct Unit { int pm, pn, e, rb, cnt; };
struct Gemm { const bf16_t* A; const bf16_t* Bt; int K; };

struct StaticOrder {
    int nM, nN, nwg, G, c;
    __device__ void init(int M, int N, int G_, int c_) { nM = M / BM; nN = N / BM; nwg = nM * nN; G = G_; c = c_; }
    __device__ __forceinline__ bool next(int i, Unit& u) const {
        const long L = (long)i * G + c; if (L >= nwg) return false;
        int wgid = (int)L; { const int q = nwg / NXCD, r = nwg % NXCD, xcd = wgid % NXCD, off = wgid / NXCD; wgid = (xcd < r ? xcd * (q + 1) : r * (q + 1) + (xcd - r) * q) + off; }
        const int nig = WGM * nN, gid = wgid / nig, fm = gid * WGM, gsz = (nM - fm) < WGM ? (nM - fm) : WGM;
        u.pm = fm + ((wgid % nig) % gsz); u.pn = (wgid % nig) / gsz; u.e = 0; u.rb = 0; u.cnt = 0; return true;
    }
    __device__ __forceinline__ unsigned row_off(const Unit&, int, int) const { return 0u; }
};
struct ListOrder {
    const PG8_LAS int* list; int n;
    const int* slot_dst; int cap;
    __device__ __forceinline__ bool next(int i, Unit& u) const {
        if (i >= n) return false;
        const PG8_LAS int* p = list + i * 8;
        u.pm = __builtin_amdgcn_readfirstlane(p[0]); u.pn = __builtin_amdgcn_readfirstlane(p[1]); u.e = __builtin_amdgcn_readfirstlane(p[2]);
        u.rb = __builtin_amdgcn_readfirstlane(p[3]); u.cnt = __builtin_amdgcn_readfirstlane(p[4]); return true;
    }
    __device__ __forceinline__ unsigned row_off(const Unit& u, int h, int R) const {
        const int pos = u.rb * 256 + h * 128 + R;
        int tok = 0; if (pos < u.cnt) tok = slot_dst[(size_t)u.e * cap + pos] >> 2;
        return (unsigned)tok * 2048u;
    }
};

__device__ __forceinline__ unsigned cvt_pk_bf16(float lo, float hi) { unsigned r; asm volatile("v_cvt_pk_bf16_f32 %0, %1, %2" : "=v"(r) : "v"(lo), "v"(hi)); return r; }

struct EpiProj {
    static constexpr bool PERM = true;
    bf16_t* O; int ldc;
    __device__ __forceinline__ void operator()(const f32x4 (&acc)[2][2][4][2], const Unit& u, int wr, int wc, int fr, int fq) const {
        const int row0 = u.pm * BM + wr * 64 + fr, col0 = u.pn * BM + wc * 32 + 8 * fq;
#pragma unroll
        for (int ai = 0; ai < 2; ++ai)
#pragma unroll
            for (int m = 0; m < 4; ++m) { bf16_t* rowp = O + (size_t)(row0 + ai * HALF + m * 16) * ldc + col0;
#pragma unroll
                for (int bj = 0; bj < 2; ++bj) { const f32x4 v0 = acc[ai][bj][m][0], v1 = acc[ai][bj][m][1];
                    u32x4 w; w.x = cvt_pk_bf16(v0[0], v0[1]); w.y = cvt_pk_bf16(v0[2], v0[3]); w.z = cvt_pk_bf16(v1[0], v1[1]); w.w = cvt_pk_bf16(v1[2], v1[3]);
                    *(u32x4*)(rowp + bj * HALF) = w; } }
    }
};
struct EpiResid {
    static constexpr bool PERM = false;
    float* H; float alpha;
    __device__ __forceinline__ void operator()(const f32x4 (&acc)[2][2][4][2], const Unit& u, int wr, int wc, int fr, int fq) const {
        const int row0 = u.pm * BM + wr * 64 + fr, col0 = u.pn * BM + wc * 32 + 4 * fq;
#pragma unroll
        for (int ai = 0; ai < 2; ++ai)
#pragma unroll
            for (int m = 0; m < 4; ++m) { float* rowp = H + (size_t)(row0 + ai * HALF + m * 16) * 1024 + col0;
#pragma unroll
                for (int bj = 0; bj < 2; ++bj)
#pragma unroll
                    for (int n = 0; n < 2; ++n) { f32x4* p = (f32x4*)(rowp + bj * HALF + n * 16); const f32x4 h = *p; *p = h * alpha + acc[ai][bj][m][n]; } }
    }
};
struct EpiSwiglu {
    static constexpr bool PERM = true;
    bf16_t* act; const float* bgu;
    __device__ __forceinline__ void operator()(const f32x4 (&acc)[2][2][4][2], const Unit& u, int wr, int wc, int fr, int fq) const {
        const int j = u.pn & 7;
        const int row0 = u.pm * BM + wr * 64 + fr, c0 = j * 128 + wc * 32 + 8 * fq;
        const float* bg = bgu + (size_t)u.e * 2048 + c0;
        f32x4 bgv[2], buv[2];
#pragma unroll
        for (int n = 0; n < 2; ++n) { bgv[n] = *(const f32x4*)(bg + 4 * n); buv[n] = *(const f32x4*)(bg + 1024 + 4 * n); }
#pragma unroll
        for (int ai = 0; ai < 2; ++ai)
#pragma unroll
            for (int m = 0; m < 4; ++m) { bf16_t* rowp = act + (size_t)(row0 + ai * HALF + m * 16) * 1024 + c0;
                float o[8];
#pragma unroll
                for (int n = 0; n < 2; ++n) { const f32x4 g4 = acc[ai][0][m][n] + bgv[n], u4 = acc[ai][1][m][n] + buv[n];
#pragma unroll
                    for (int q = 0; q < 4; ++q) { const float g = fminf(g4[q], 7.0f), up = fminf(fmaxf(u4[q], -7.0f), 7.0f);
                        const float sg = 1.0f / (1.0f + __expf(-1.702f * g)); o[4 * n + q] = (up + 1.0f) * g * sg; } }
                u32x4 w; w.x = cvt_pk_bf16(o[0], o[1]); w.y = cvt_pk_bf16(o[2], o[3]); w.z = cvt_pk_bf16(o[4], o[5]); w.w = cvt_pk_bf16(o[6], o[7]);
                *(u32x4*)rowp = w; }
    }
};
struct EpiDown {
    static constexpr bool PERM = true;
    bf16_t* y4; const float* bdn; const int* slot_dst; const float* slot_gate; int cap;
    __device__ __forceinline__ void operator()(const f32x4 (&acc)[2][2][4][2], const Unit& u, int wr, int wc, int fr, int fq) const {
        const int jn = u.pn & 3;
        const int c0 = jn * 256 + wc * 32 + 8 * fq;
        const float* bd = bdn + (size_t)u.e * 1024 + c0;
        f32x4 bv[2][2];
#pragma unroll
        for (int bj = 0; bj < 2; ++bj)
#pragma unroll
            for (int n = 0; n < 2; ++n) bv[bj][n] = *(const f32x4*)(bd + bj * HALF + 4 * n);
#pragma unroll
        for (int ai = 0; ai < 2; ++ai)
#pragma unroll
            for (int m = 0; m < 4; ++m) { const int pos = u.rb * 256 + ai * HALF + wr * 64 + m * 16 + fr;
                if (pos < u.cnt) { const size_t si = (size_t)u.e * cap + pos; const int dst = slot_dst[si]; const float gt = slot_gate[si];
                    bf16_t* rowp = y4 + (size_t)dst * 1024 + c0;
#pragma unroll
                    for (int bj = 0; bj < 2; ++bj) { const f32x4 v0 = (acc[ai][bj][m][0] + bv[bj][0]) * gt, v1 = (acc[ai][bj][m][1] + bv[bj][1]) * gt;
                        u32x4 w; w.x = cvt_pk_bf16(v0[0], v0[1]); w.y = cvt_pk_bf16(v0[2], v0[3]); w.z = cvt_pk_bf16(v1[0], v1[1]); w.w = cvt_pk_bf16(v1[2], v1[3]);
                        *(u32x4*)(rowp + bj * HALF) = w; } } }
    }
};

template <class Epi, class Sched, bool GATHER>
__device__ __forceinline__ void gemm_phase(PG8_LAS unsigned char* lds, const Gemm g, const Sched& S, const Epi& E) {
    int tid = threadIdx.x; asm volatile("" : "+v"(tid));
    const int wid = __builtin_amdgcn_readfirstlane(tid >> 6), lane = tid & 63, wr = wid >> 2, wc = wid & 3, fr = lane & 15, fq = lane >> 4;
    const int K = g.K, nt = K / BK;
    unsigned voffA[2], voffB[2]; int RA[2], CA[2];
#pragma unroll
    for (int i = 0; i < 2; ++i) { int R, C; stage_rc(tid * 16 + i * 8192, R, C); const int Rb = Epi::PERM ? ((R & ~31) + perm32(R & 31)) : R;
        RA[i] = R; CA[i] = C; voffA[i] = (unsigned)(R * K + C) * 2u; voffB[i] = (unsigned)(Rb * K + C) * 2u; }
    const size_t kstep = (size_t)(BK * 2);
    const size_t hstep = (size_t)HALF * K * 2;
    const size_t tstep = 2 * hstep;
    const size_t hstepA = GATHER ? 0 : hstep;
    const unsigned ldsw = (unsigned)wid * 1024u;
    const int aoff = lds_byte(wr * 64 + fr, fq * 8), boff = lds_byte(wc * 32 + fr, fq * 8);
#define PG8_SA(b, h) (((b) * 2 + (h)) * HTB)
#define PG8_SB(b, h) ((4 + (b) * 2 + (h)) * HTB)
#define PG8_STAGE(bufoff, gbase, voff) do { _Pragma("unroll") for (int _i = 0; _i < 2; ++_i) \
        __builtin_amdgcn_global_load_lds((const unsigned*)((const char*)(gbase) + (voff)[_i]), (PG8_LAS unsigned*)(lds + (bufoff) + ldsw + _i * 8192), 16, 0, 0); } while (0)
#define PG8_LDA(dst, b, h) do { _Pragma("unroll") for (int m = 0; m < 4; ++m) _Pragma("unroll") for (int k = 0; k < 2; ++k) dst[m][k] = *(const PG8_LAS bf16x8*)(lds + PG8_SA(b, h) + aoff + m * 2048 + k * 1024); } while (0)
#define PG8_LDB(dst, b, h) do { _Pragma("unroll") for (int n = 0; n < 2; ++n) _Pragma("unroll") for (int k = 0; k < 2; ++k) dst[n][k] = *(const PG8_LAS bf16x8*)(lds + PG8_SB(b, h) + boff + n * 2048 + k * 1024); } while (0)
#define PG8_MMA(ai, bj, At, Bt) do { __builtin_amdgcn_s_setprio(1); _Pragma("unroll") for (int m = 0; m < 4; ++m) _Pragma("unroll") for (int n = 0; n < 2; ++n) _Pragma("unroll") for (int k = 0; k < 2; ++k) \
        acc[ai][bj][m][n] = __builtin_amdgcn_mfma_f32_16x16x32_bf16(Bt[n][k], At[m][k], acc[ai][bj][m][n], 0, 0, 0); __builtin_amdgcn_s_setprio(0); } while (0)
#define PG8_WAIT_V(n) asm volatile("s_waitcnt vmcnt(" #n ")" ::: "memory")
#define PG8_WAIT_L(n) asm volatile("s_waitcnt lgkmcnt(" #n ")" ::: "memory")
#define PG8_BAR __builtin_amdgcn_s_barrier()
#define PG8_SCHED __builtin_amdgcn_sched_barrier(0)
    Unit cur, nxt; int ui = 0;
    if (!S.next(0, cur)) return;
    f32x4 acc[2][2][4][2];
#pragma unroll
    for (int a = 0; a < 2; ++a)
#pragma unroll
        for (int b = 0; b < 2; ++b)
#pragma unroll
            for (int m = 0; m < 4; ++m)
#pragma unroll
                for (int n = 0; n < 2; ++n) acc[a][b][m][n] = (f32x4){0.f, 0.f, 0.f, 0.f};
    bf16x8 At[4][2], B0[2][2], B1[2][2];
    unsigned c0[2], c1[2], n0[2], n1[2];
#pragma unroll
    for (int i = 0; i < 2; ++i) {
        if (GATHER) { c0[i] = S.row_off(cur, 0, RA[i]) + (unsigned)CA[i] * 2u; c1[i] = S.row_off(cur, 1, RA[i]) + (unsigned)CA[i] * 2u; }
        else { c0[i] = voffA[i]; c1[i] = voffA[i]; }
        n0[i] = c0[i]; n1[i] = c1[i];
    }
    const char* cA = GATHER ? (const char*)g.A : (const char*)g.A + (size_t)cur.pm * tstep; const char* cB = (const char*)g.Bt + (size_t)cur.pn * tstep;
    PG8_STAGE(PG8_SB(0, 0), cB, voffB); PG8_STAGE(PG8_SB(0, 1), cB + hstep, voffB); PG8_STAGE(PG8_SA(0, 0), cA, c0); PG8_STAGE(PG8_SA(0, 1), cA + hstepA, c1);
    if (wr == 1) PG8_BAR;
    PG8_WAIT_V(2); PG8_BAR;
    PG8_STAGE(PG8_SB(1, 0), cB + kstep, voffB); PG8_STAGE(PG8_SA(1, 0), cA + kstep, c0); PG8_STAGE(PG8_SB(1, 1), cB + hstep + kstep, voffB);
    PG8_WAIT_V(6); PG8_BAR;
    for (;;) {
        const bool has_next = S.next(ui + 1, nxt);
        const char* nA = has_next ? (GATHER ? (const char*)g.A : (const char*)g.A + (size_t)nxt.pm * tstep) : cA; const char* nB = has_next ? (const char*)g.Bt + (size_t)nxt.pn * tstep : cB;
        if (GATHER) {
#pragma unroll
            for (int i = 0; i < 2; ++i) { if (has_next) { n0[i] = S.row_off(nxt, 0, RA[i]) + (unsigned)CA[i] * 2u; n1[i] = S.row_off(nxt, 1, RA[i]) + (unsigned)CA[i] * 2u; } else { n0[i] = c0[i]; n1[i] = c1[i]; } }
        }
        for (int t = 0; t < nt; t += 2) {
            const bool last = (t == nt - 2);
            const char* a1 = cA + (size_t)(t + 1) * kstep;
            const char* a2 = last ? nA : cA + (size_t)(t + 2) * kstep; const char* b2 = last ? nB : cB + (size_t)(t + 2) * kstep;
            const char* a3 = a2 + kstep; const char* b3 = b2 + kstep;
            unsigned s0[2], s1[2];
#pragma unroll
            for (int i = 0; i < 2; ++i) { s0[i] = (GATHER && last) ? n0[i] : c0[i]; s1[i] = (GATHER && last) ? n1[i] : c1[i]; }
            PG8_LDB(B0, 0, 0); PG8_LDB(B1, 0, 1); PG8_SCHED; PG8_LDA(At, 0, 0); PG8_STAGE(PG8_SA(1, 1), a1 + hstepA, c1);
            PG8_WAIT_V(8); PG8_WAIT_L(0); PG8_BAR; PG8_MMA(0, 0, At, B0); PG8_MMA(0, 1, At, B1); PG8_BAR; PG8_SCHED;
            PG8_LDA(At, 0, 1); PG8_STAGE(PG8_SB(0, 0), b2, voffB); PG8_STAGE(PG8_SB(0, 1), b2 + hstep, voffB); PG8_STAGE(PG8_SA(0, 0), a2, s0);
            PG8_WAIT_V(8); PG8_WAIT_L(0); PG8_BAR; PG8_MMA(1, 0, At, B0); PG8_MMA(1, 1, At, B1); PG8_BAR; PG8_SCHED;
            PG8_LDB(B0, 1, 0); PG8_LDB(B1, 1, 1); PG8_SCHED; PG8_LDA(At, 1, 0); PG8_STAGE(PG8_SA(0, 1), a2 + hstepA, s1);
            PG8_WAIT_V(8); PG8_WAIT_L(0); PG8_BAR; PG8_MMA(0, 0, At, B0); PG8_MMA(0, 1, At, B1); PG8_BAR; PG8_SCHED;
            PG8_LDA(At, 1, 1); PG8_STAGE(PG8_SB(1, 0), b3, voffB); PG8_STAGE(PG8_SB(1, 1), b3 + hstep, voffB); PG8_STAGE(PG8_SA(1, 0), a3, s0);
            PG8_WAIT_V(8); PG8_WAIT_L(0); PG8_BAR; PG8_MMA(1, 0, At, B0); PG8_MMA(1, 1, At, B1); PG8_BAR; PG8_SCHED;
        }
        if (wr == 0) PG8_BAR;
        E(acc, cur, wr, wc, fr, fq);
        if (!has_next) break;
#pragma unroll
        for (int a = 0; a < 2; ++a)
#pragma unroll
            for (int b = 0; b < 2; ++b)
#pragma unroll
                for (int m = 0; m < 4; ++m)
#pragma unroll
                    for (int n = 0; n < 2; ++n) acc[a][b][m][n] = (f32x4){0.f, 0.f, 0.f, 0.f};
        cur = nxt; cA = nA; cB = nB; ++ui;
#pragma unroll
        for (int i = 0; i < 2; ++i) { c0[i] = n0[i]; c1[i] = n1[i]; }
        if (wr == 1) PG8_BAR;
    }
    PG8_WAIT_V(0);
    PG8_BAR;
#undef PG8_SA
#undef PG8_SB
#undef PG8_STAGE
#undef PG8_LDA
#undef PG8_LDB
#undef PG8_MMA
#undef PG8_WAIT_V
#undef PG8_WAIT_L
#undef PG8_BAR
#undef PG8_SCHED
}
}

constexpr int NWAVES = 8;
constexpr int BATCH = 32, SEQ = 2048, D = 1024, DEPTH = 2;
constexpr int M = BATCH * SEQ;
constexpr int NPROJ = 3344, NPROJ_PAD = 3584;
constexpr int NEXP = 32, TOPK = 4, DFF = 1024;
constexpr int CAP = M;
constexpr float LN_EPS = 1e-5f, RMS_EPS = 1e-6f;
constexpr float ALPHA = 1.4142135623730951f;
constexpr int C_GQ = 0, C_GK = 256, C_GV = 512, C_GLR = 1024, C_GOG = 1040, C_HQ = 1552, C_HF = 1808, C_HI = 2064, C_HOG = 2320, C_CB = 2576, C_CC = 2832, C_CH = 3088;

constexpr size_t MiB = 1u << 20;
constexpr size_t WS_CTL = 0, CTL_ZERO_BYTES = 1 * MiB;
constexpr size_t W_IN_B = (size_t)NPROJ_PAD * D * 2, W_OUT_B = (size_t)D * D * 2, W_GU_B = (size_t)NEXP * 2048 * D * 2, W_DN_B = (size_t)NEXP * D * DFF * 2;
constexpr size_t W_LAYER_B = W_IN_B + W_OUT_B + W_GU_B + W_DN_B;
constexpr size_t WS_W = 2 * MiB;
constexpr size_t WS_HB = 404 * MiB;
constexpr size_t WS_R1 = 532 * MiB;
constexpr size_t WS_PROJ = WS_R1, WS_Y = WS_R1 + 448 * MiB, WS_ACT = WS_R1;
constexpr size_t WS_Y4 = 1108 * MiB;
constexpr size_t WS_SLOT = 1620 * MiB;
constexpr size_t WS_END = 1636 * MiB;
static_assert((size_t)(M * 4 + NEXP * 256) * 1024 * 2 <= 576 * MiB, "act fits the proj|Y region");
constexpr int CW_BAR = 4096;
constexpr int CW_CNT = 16384;

constexpr int RING_BYTES = 131072;
constexpr int MISC_OFF = RING_BYTES;
constexpr int ULIST_OFF = RING_BYTES + 256;
constexpr int TOK_OFF = RING_BYTES + 256 + 2048;
constexpr int LDS_BYTES = 147456;
static_assert(TOK_OFF + 3 * 4096 + 512 <= LDS_BYTES, "LDS map");

#define GAS __attribute__((address_space(1)))
#define LAS __attribute__((address_space(3)))
typedef unsigned short bf16;
typedef unsigned v4u __attribute__((ext_vector_type(4)));
typedef unsigned v2u __attribute__((ext_vector_type(2)));
typedef float f32x4 __attribute__((ext_vector_type(4)));
typedef GAS unsigned gu32;
#define RLX_AGENT __ATOMIC_RELAXED, __HIP_MEMORY_SCOPE_AGENT
#define LDS_WAIT() asm volatile("s_waitcnt lgkmcnt(0)" ::: "memory")
__device__ __forceinline__ unsigned f2bf(float f) { unsigned u = __builtin_bit_cast(unsigned, f); return (u + 0x7fffu + ((u >> 16) & 1u)) >> 16; }
__device__ __forceinline__ unsigned pk2(float lo, float hi) { return f2bf(lo) | (f2bf(hi) << 16); }
__device__ __forceinline__ float bf2f(unsigned short b) { return __builtin_bit_cast(float, ((unsigned)b) << 16); }
__device__ __forceinline__ float bflo(unsigned w) { return __builtin_bit_cast(float, w << 16); }
__device__ __forceinline__ float bfhi(unsigned w) { return __builtin_bit_cast(float, w & 0xffff0000u); }

#define XB_TMO      128
#define XB_XCNT(j)  (256  + 64 * (j))
#define XB_XSUB(j)  (1280 + 64 * (j))
#define XB_XGEN(j)  (2304 + 64 * (j))
#define XB_TOP      3328
#define XB_TOPGEN   3392
#define XCD_BAR_WORDS 3456
#define XB_SPIN_CAP (1u << 18)
__device__ __forceinline__ unsigned xb_ld(unsigned* p)              { return __hip_atomic_load(p, __ATOMIC_RELAXED, __HIP_MEMORY_SCOPE_AGENT); }
__device__ __forceinline__ unsigned xb_add(unsigned* p, unsigned v) { return __hip_atomic_fetch_add(p, v, __ATOMIC_RELAXED, __HIP_MEMORY_SCOPE_AGENT); }
__device__ __forceinline__ unsigned xb_xcc_id() { return (unsigned)__builtin_amdgcn_s_getreg((3 << 11) | 20) & 0xFu; }
#define XB_SPIN(cond, bar) do { unsigned _sp = 0; while (cond) { __builtin_amdgcn_s_sleep(1); \
    if ((++_sp & 255u) == 0u) { if (xb_ld(&(bar)[XB_TMO])) break; if (_sp > XB_SPIN_CAP) { atomicAdd(&(bar)[XB_TMO], 1u); break; } } } } while (0)
struct XcdBarrier { unsigned* bar; unsigned x; volatile LAS unsigned* st; };
__device__ __forceinline__ XcdBarrier xcd_barrier_post(unsigned* bar, volatile LAS unsigned* st) {
    XcdBarrier b; b.bar = bar; b.x = xb_xcc_id(); b.st = st;
    if (threadIdx.x == 0) (void)xb_add(&bar[XB_XCNT(b.x)], 1u);
    return b;
}
__device__ __forceinline__ void xcd_barrier_complete(unsigned* bar, unsigned x, unsigned& nloc, unsigned& nx) {
    const unsigned G = gridDim.x * gridDim.y * gridDim.z;
    unsigned sum, cnt, mine, sp = 0u;
    for (;;) {
        sum = 0u; cnt = 0u; mine = 0u;
#pragma unroll
        for (unsigned j = 0; j < 16; ++j) { const unsigned c = xb_ld(&bar[XB_XCNT(j)]); sum += c; cnt += (c > 0u) ? 1u : 0u; mine = (j == x) ? c : mine; }
        if (sum == G) break;
        __builtin_amdgcn_s_sleep(1);
        if ((++sp & 255u) == 0u) { if (xb_ld(&bar[XB_TMO])) break; if (sp > XB_SPIN_CAP) { atomicAdd(&bar[XB_TMO], 1u); break; } }
    }
    nloc = mine > 0u ? mine : 1u; nx = cnt > 0u ? cnt : 1u;
}
__device__ __forceinline__ void xcd_barrier(const XcdBarrier& b) {
    asm volatile("s_waitcnt vmcnt(0)" ::: "memory");
    __syncthreads();
    if (threadIdx.x == 0) {
        unsigned* bar = b.bar;
        __builtin_amdgcn_s_waitcnt(0);
        unsigned nloc = b.st[0], nx = b.st[1];
        if (nloc == 0u) { xcd_barrier_complete(bar, b.x, nloc, nx); b.st[0] = nloc; b.st[1] = nx; }
        const unsigned old = xb_add(&bar[XB_XSUB(b.x)], 1u);
        const unsigned gen = old / nloc;
        if (old + 1u == (gen + 1u) * nloc) {
            __builtin_amdgcn_fence(__ATOMIC_RELEASE, "agent");
            asm volatile("s_waitcnt vmcnt(0)" ::: "memory");
            const unsigned og = xb_add(&bar[XB_TOP], 1u);
            const unsigned tg = og / nx;
            if (og + 1u == (tg + 1u) * nx) xb_add(&bar[XB_TOPGEN], 1u);
            else XB_SPIN(xb_ld(&bar[XB_TOPGEN]) == tg, bar);
            __builtin_amdgcn_fence(__ATOMIC_ACQUIRE, "agent");
            xb_add(&bar[XB_XGEN(b.x)], 1u);
            asm volatile("s_waitcnt vmcnt(0)" ::: "memory");
        } else {
            XB_SPIN(xb_ld(&bar[XB_XGEN(b.x)]) == gen, bar);
            __builtin_amdgcn_fence(__ATOMIC_ACQUIRE, "agent");
            asm volatile("s_waitcnt vmcnt(0)" ::: "memory");
        }
    }
    __syncthreads();
}

struct Frame {
    LAS unsigned char* lds;
    volatile LAS unsigned* MISC;
    gu32* ctl;
    int tid, lane, wave, vcu, G;
    const __attribute__((address_space(4))) unsigned char* ka;
    float* H;
    unsigned char* ws;
};
__device__ __forceinline__ const float* inp(const Frame& F, int i) { return *(const float* const __attribute__((address_space(4)))*)(F.ka + 8 * i); }
__device__ __forceinline__ bf16* w_in_t(Frame& F, int l)  { return (bf16*)(F.ws + WS_W + (size_t)l * W_LAYER_B); }
__device__ __forceinline__ bf16* w_out_t(Frame& F, int l) { return (bf16*)(F.ws + WS_W + (size_t)l * W_LAYER_B + W_IN_B); }
__device__ __forceinline__ bf16* w_gu_t(Frame& F, int l)  { return (bf16*)(F.ws + WS_W + (size_t)l * W_LAYER_B + W_IN_B + W_OUT_B); }
__device__ __forceinline__ bf16* w_dn_t(Frame& F, int l)  { return (bf16*)(F.ws + WS_W + (size_t)l * W_LAYER_B + W_IN_B + W_OUT_B + W_GU_B); }

__device__ __forceinline__ float wave_sum(float v) {
#pragma unroll
    for (int o = 1; o < 64; o <<= 1) v += __shfl_xor(v, o);
    return v;
}
__device__ __forceinline__ float wave_max(float v) {
#pragma unroll
    for (int o = 1; o < 64; o <<= 1) v = fmaxf(v, __shfl_xor(v, o));
    return v;
}

template <int MODE>
__device__ __forceinline__ void p0_transpose_item(const float* W, int K, int N, bf16* WT, LAS float* scr, int item, int lane) {
    const int nblk = (N + 31) / 32, kb = item / nblk, nb = item % nblk, k0 = 64 * kb, n0 = 32 * nb;
    const bool nok = (n0 + (lane & 31)) < N;
#pragma unroll 8
    for (int i = 0; i < 32; ++i) { const int kk = 2 * i + (lane >> 5); scr[kk * 33 + (lane & 31)] = nok ? W[(size_t)(k0 + kk) * N + n0 + (lane & 31)] : 0.f; }
    LDS_WAIT(); asm volatile("" ::: "memory");
    const int c = lane & 7;
#pragma unroll
    for (int j = 0; j < 4; ++j) { const int n = (lane >> 3) + 8 * j; const LAS float* s = scr + (8 * c) * 33 + n;
        v4u o; o.x = pk2(s[0 * 33], s[1 * 33]); o.y = pk2(s[2 * 33], s[3 * 33]); o.z = pk2(s[4 * 33], s[5 * 33]); o.w = pk2(s[6 * 33], s[7 * 33]);
        const int ns = n0 + n;
        int nd = ns;
        if (MODE == 1) { const int half = ns >> 10, cc = ns & 1023; nd = (cc >> 7) * 256 + half * 128 + (cc & 127); }
        if (ns < N) *(GAS v4u*)(WT + (size_t)nd * K + k0 + 8 * c) = o; }
    LDS_WAIT(); asm volatile("" ::: "memory");
}
__device__ __forceinline__ void ln_row(f32x4 (&v)[4], const float* g, const float* b, int lane) {
    float s = 0.f;
#pragma unroll
    for (int j = 0; j < 4; ++j) s += (v[j].x + v[j].y) + (v[j].z + v[j].w);
    const float mean = wave_sum(s) * (1.f / D); float s2 = 0.f;
#pragma unroll
    for (int j = 0; j < 4; ++j) { v[j] = v[j] - mean; s2 += (v[j].x * v[j].x + v[j].y * v[j].y) + (v[j].z * v[j].z + v[j].w * v[j].w); }
    const float rstd = 1.f / sqrtf(wave_sum(s2) * (1.f / D) + LN_EPS);
#pragma unroll
    for (int j = 0; j < 4; ++j) { const f32x4 gg = *(const f32x4*)(g + 4 * lane + 256 * j), bb = *(const f32x4*)(b + 4 * lane + 256 * j); v[j] = v[j] * rstd * gg + bb; }
}
__device__ __forceinline__ void store_row(const f32x4 (&v)[4], float* orow, bf16* brow, int lane) {
#pragma unroll
    for (int j = 0; j < 4; ++j) { *(f32x4*)(orow + 4 * lane + 256 * j) = v[j];
        v2u w; w.x = pk2(v[j].x, v[j].y); w.y = pk2(v[j].z, v[j].w); *(v2u*)(brow + 4 * lane + 256 * j) = w; }
}
__device__ __forceinline__ void p0_prologue(Frame& F) {
    LAS float* scr = (LAS float*)(F.lds + F.wave * 16384);
    const int gw = F.vcu * NWAVES + F.wave, NGW = F.G * NWAVES;
    constexpr int I_IN = (D / 64) * ((NPROJ + 31) / 32), I_OUT = (D / 64) * (D / 32), I_GU = (D / 64) * (2048 / 32), I_DN = (DFF / 64) * (D / 32);
    constexpr int PER_LAYER = I_IN + I_OUT + NEXP * I_GU + NEXP * I_DN;
    for (int it = gw; it < DEPTH * PER_LAYER; it += NGW) {
        const int l = it / PER_LAYER; int r = it % PER_LAYER;
        if (r < I_IN) { p0_transpose_item<0>(inp(F, 3) + (size_t)l * D * NPROJ, D, NPROJ, w_in_t(F, l), scr, r, F.lane); continue; } r -= I_IN;
        if (r < I_OUT) { p0_transpose_item<0>(inp(F, 10) + (size_t)l * D * D, D, D, w_out_t(F, l), scr, r, F.lane); continue; } r -= I_OUT;
        if (r < NEXP * I_GU) { const int e = r / I_GU; p0_transpose_item<1>(inp(F, 15) + ((size_t)l * NEXP + e) * D * 2048, D, 2048, w_gu_t(F, l) + (size_t)e * 2048 * D, scr, r % I_GU, F.lane); continue; } r -= NEXP * I_GU;
        { const int e = r / I_DN; p0_transpose_item<0>(inp(F, 17) + ((size_t)l * NEXP + e) * DFF * D, DFF, D, w_dn_t(F, l) + (size_t)e * D * DFF, scr, r % I_DN, F.lane); }
    }
    for (int l = 0; l < DEPTH; ++l) { v4u* z = (v4u*)(w_in_t(F, l) + (size_t)NPROJ * D); const int nz = (NPROJ_PAD - NPROJ) * D * 2 / 16;
        for (int i = gw * 64 + F.lane; i < nz; i += NGW * 64) z[i] = (v4u){0u, 0u, 0u, 0u}; }
    bf16* HB = (bf16*)(F.ws + WS_HB);
    for (int m = gw; m < M; m += NGW) { f32x4 v[4]; const float* xr = inp(F, 0) + (size_t)m * D;
#pragma unroll
        for (int j = 0; j < 4; ++j) v[j] = *(const f32x4*)(xr + 4 * F.lane + 256 * j);
        ln_row(v, inp(F, 1), inp(F, 2), F.lane); store_row(v, F.H + (size_t)m * D, HB + (size_t)m * D, F.lane); }
}

__device__ __forceinline__ float sigmoidf_(float x) { return 1.0f / (1.0f + __expf(-x)); }
__device__ __forceinline__ float siluf_(float x) { return x * sigmoidf_(x); }
template <int DV, bool GLA>
__device__ __forceinline__ void scan_item(Frame& F, int l, int b, int hd) {
    constexpr int DG = 512 / DV, DPG = 64 / DG, TB = 16;
    LAS float* sq = (LAS float*)(F.lds);
    LAS float* sk = sq + TB * 64;
    LAS float* sa = sk + TB * 64;
    LAS float* sv = sa + TB * 64;
    LAS float* sg = sv + TB * DV;
    LAS float* so = sg + TB * DV;
    LAS float* sW = so + TB * DG * DV;
    LAS float* sb = sW + 16 * 64;
    const bf16* proj = (const bf16*)(F.ws + WS_PROJ); bf16* Y = (bf16*)(F.ws + WS_Y);
    const int qc = GLA ? C_GQ + hd * 64 : C_HQ + hd * 64, kc = GLA ? C_GK + hd * 64 : C_HF + hd * 64, vc = GLA ? C_GV + hd * 128 : C_HI + hd * 64,
              ogc = GLA ? C_GOG + hd * 128 : C_HOG + hd * 64, yc = GLA ? hd * 128 : 512 + hd * 64;
    const int tid = F.tid;
    __syncthreads();
    if (GLA) { for (int i = tid; i < 16 * 64; i += 512) sW[i] = inp(F, 4)[(size_t)l * 16 * 256 + (i >> 6) * 256 + hd * 64 + (i & 63)];
        if (tid < 64) sb[tid] = inp(F, 5)[l * 256 + hd * 64 + tid]; }
    float lbv[2] = {0.f, 0.f};
    if (!GLA && l > 0) {
#pragma unroll
        for (int h2 = 0; h2 < 2; ++h2) { const int dd = (tid & 31) + 32 * h2; const float r0 = inp(F, 7)[hd * 64 + dd], r1 = inp(F, 7)[256 + hd * 64 + dd]; lbv[h2] = 1.0f / (1.0f + __expf(r0 - r1)); } }
    const float* gn = GLA ? inp(F, 6) + l * 128 : inp(F, 8) + l * 64;
    float S[DPG];
#pragma unroll
    for (int i = 0; i < DPG; ++i) S[i] = 0.f;
    const int v_ = tid % DV, dg = tid / DV;
    __syncthreads();
    for (int t0 = 0; t0 < SEQ; t0 += TB) {
        {
            const int tt = tid >> 5, c = tid & 31; const bf16* prow = proj + (size_t)(b * SEQ + t0 + tt) * NPROJ_PAD;
#pragma unroll
            for (int h2 = 0; h2 < 2; ++h2) { const int dd = c + 32 * h2; float q, k, a;
                if (GLA) { q = bf2f(prow[qc + dd]) * 0.125f; k = bf2f(prow[kc + dd]); float lg = sb[dd];
#pragma unroll
                    for (int r = 0; r < 16; ++r) lg += bf2f(prow[C_GLR + r]) * sW[r * 64 + dd];
                    const float ls = fminf(lg, 0.f) - log1pf(__expf(-fabsf(lg)));
                    a = __expf(ls * (1.0f / 16.0f)); }
                else { q = siluf_(bf2f(prow[qc + dd])); const float z = bf2f(prow[kc + dd]); const float f = lbv[h2] + (1.0f - lbv[h2]) * sigmoidf_(z); a = f; k = 1.0f - f; }
                sq[tt * 64 + dd] = q; sk[tt * 64 + dd] = k; sa[tt * 64 + dd] = a; }
#pragma unroll
            for (int j = 0; j < DV / 32; ++j) { sv[tt * DV + c + 32 * j] = bf2f(prow[vc + c + 32 * j]); sg[tt * DV + c + 32 * j] = bf2f(prow[ogc + c + 32 * j]); }
        }
        __syncthreads();
        for (int tt = 0; tt < TB; ++tt) {
            const float vv = sv[tt * DV + v_]; float o = 0.f;
#pragma unroll
            for (int i = 0; i < DPG; ++i) { const int d = dg * DPG + i; S[i] = sa[tt * 64 + d] * S[i] + sk[tt * 64 + d] * vv; o += sq[tt * 64 + d] * S[i]; }
            so[(tt * DG + dg) * DV + v_] = o;
        }
        __syncthreads();
        {
#pragma unroll
            for (int h2 = 0; h2 < 2; ++h2) { const int tt = 2 * F.wave + h2; float ov[DV / 64]; float ss = 0.f;
#pragma unroll
                for (int j = 0; j < DV / 64; ++j) { const int v = F.lane + 64 * j; float o = 0.f;
#pragma unroll
                    for (int g2 = 0; g2 < DG; ++g2) o += so[(tt * DG + g2) * DV + v];
                    ov[j] = o; ss += o * o; }
                ss = wave_sum(ss); const float r = 1.0f / sqrtf(ss * (1.0f / DV) + RMS_EPS);
                bf16* yrow = Y + (size_t)(b * SEQ + t0 + tt) * D + yc;
#pragma unroll
                for (int j = 0; j < DV / 64; ++j) { const int v = F.lane + 64 * j; yrow[v] = (bf16)f2bf(ov[j] * r * gn[v] * siluf_(sg[tt * DV + v])); } }
        }
        __syncthreads();
    }
}
__device__ __forceinline__ void p2_scan(Frame& F, int l) {
    for (int it = F.vcu; it < BATCH * 8; it += F.G) { const int b = it >> 3, u = it & 7;
        if (u < 4) scan_item<128, true>(F, l, b, u); else scan_item<64, false>(F, l, b, u - 4); }
    const bf16* proj = (const bf16*)(F.ws + WS_PROJ); bf16* Y = (bf16*)(F.ws + WS_Y);
    const float* cw = inp(F, 9) + (size_t)l * 3 * 256;
    for (long idx = (long)F.vcu * 512 + F.tid; idx < (long)M * 32; idx += (long)F.G * 512) { const int row = (int)(idx >> 5), ch = (int)(idx & 31) * 8, t = row & (SEQ - 1);
        float u_[3][8];
#pragma unroll
        for (int j = 0; j < 3; ++j) { const int dt = 2 - j;
            if (t - dt >= 0) { const bf16* pr = proj + (size_t)(row - dt) * NPROJ_PAD; const v4u cc = *(const v4u*)(pr + C_CC + ch), hh = *(const v4u*)(pr + C_CH + ch);
#pragma unroll
                for (int q = 0; q < 4; ++q) { u_[j][2 * q] = bflo(cc[q]) * bflo(hh[q]); u_[j][2 * q + 1] = bfhi(cc[q]) * bfhi(hh[q]); } }
            else {
#pragma unroll
                for (int q = 0; q < 8; ++q) u_[j][q] = 0.f; } }
        const v4u bb = *(const v4u*)(proj + (size_t)row * NPROJ_PAD + C_CB + ch); float o[8];
#pragma unroll
        for (int q = 0; q < 8; ++q) { const float cv = cw[ch + q] * u_[0][q] + cw[256 + ch + q] * u_[1][q] + cw[512 + ch + q] * u_[2][q]; const float bq = (q & 1) ? bfhi(bb[q >> 1]) : bflo(bb[q >> 1]); o[q] = bq * cv; }
        v4u w; w.x = pk2(o[0], o[1]); w.y = pk2(o[2], o[3]); w.z = pk2(o[4], o[5]); w.w = pk2(o[6], o[7]);
        *(v4u*)(Y + (size_t)row * D + 768 + ch) = w; }
}

__device__ __forceinline__ void p4_ln_router(Frame& F, int l) {
    LAS float* sWr = (LAS float*)F.lds;
    LAS int* tokE = (LAS int*)(F.lds + TOK_OFF); LAS int* tokP = tokE + 1024; LAS float* tokG = (LAS float*)(tokP + 1024);
    LAS int* lcnt = (LAS int*)(tokG + 1024); LAS int* gbase = lcnt + 32;
    const float* Wr = inp(F, 13) + (size_t)l * D * NEXP; const float* br = inp(F, 14) + l * NEXP;
    bf16* HB = (bf16*)(F.ws + WS_HB);
    int* slot_dst = (int*)(F.ws + WS_SLOT); float* slot_gate = (float*)(F.ws + WS_SLOT + 8 * MiB);
    gu32* gcnt = F.ctl + CW_CNT + l * 64;
    __syncthreads();
    for (int i = F.tid; i < D * NEXP; i += 512) { const int d = i >> 5, e = i & 31; sWr[e * D + d] = Wr[i]; }
    for (int tb = F.vcu; tb < M / 256; tb += F.G) {
        if (F.tid < 32) lcnt[F.tid] = 0;
        __syncthreads();
        for (int r = 0; r < 32; ++r) { const int tl = F.wave * 32 + r, m = tb * 256 + tl;
            f32x4 v[4]; float* hr = F.H + (size_t)m * D;
#pragma unroll
            for (int j = 0; j < 4; ++j) v[j] = *(const f32x4*)(hr + 4 * F.lane + 256 * j);
            ln_row(v, inp(F, 11) + l * D, inp(F, 12) + l * D, F.lane); store_row(v, hr, HB + (size_t)m * D, F.lane);
            float p[32];
#pragma unroll
            for (int e = 0; e < 32; ++e) { float s = 0.f;
#pragma unroll
                for (int j = 0; j < 4; ++j) { const f32x4 w4 = *(const LAS f32x4*)(sWr + e * D + 4 * F.lane + 256 * j); s += (v[j].x * w4.x + v[j].y * w4.y) + (v[j].z * w4.z + v[j].w * w4.w); }
                p[e] = s; }
#pragma unroll
            for (int st = 16; st >= 1; st >>= 1) { const bool up = (F.lane & st) != 0;
#pragma unroll
                for (int i = 0; i < st; ++i) { const float send = up ? p[i] : p[i + st]; const float keep = up ? p[i + st] : p[i]; p[i] = keep + __shfl_xor(send, st); } }
            float lg = p[0] + __shfl_xor(p[0], 32); lg += br[F.lane & 31];
            float val = lg; float tv[4]; int te[4];
#pragma unroll
            for (int k = 0; k < 4; ++k) { const float mx = wave_max(val); const unsigned long long bal = __ballot(val == mx); const int e = __builtin_ctzll(bal) & 31; tv[k] = mx; te[k] = e; if ((F.lane & 31) == e) val = -3.0e38f; }
            const float e1 = __expf(tv[1] - tv[0]), e2 = __expf(tv[2] - tv[0]), e3 = __expf(tv[3] - tv[0]); const float inv = 1.0f / (1.0f + e1 + e2 + e3);
            if (F.lane < 4) { const int ek = F.lane == 0 ? te[0] : F.lane == 1 ? te[1] : F.lane == 2 ? te[2] : te[3];
                const float gk = (F.lane == 0 ? 1.0f : F.lane == 1 ? e1 : F.lane == 2 ? e2 : e3) * inv;
                const int lp = __hip_atomic_fetch_add(lcnt + ek, 1, __ATOMIC_RELAXED, __HIP_MEMORY_SCOPE_WORKGROUP);
                tokE[tl * 4 + F.lane] = ek; tokP[tl * 4 + F.lane] = lp; tokG[tl * 4 + F.lane] = gk; }
        }
        __syncthreads();
        if (F.tid < 32) gbase[F.tid] = (int)__hip_atomic_fetch_add(gcnt + F.tid, (unsigned)lcnt[F.tid], RLX_AGENT);
        __syncthreads();
        for (int i = F.tid; i < 1024; i += 512) { const int e = tokE[i], pos = gbase[e] + tokP[i]; const size_t si = (size_t)e * CAP + pos;
            slot_dst[si] = (tb * 256 + (i >> 2)) * 4 + (i & 3); slot_gate[si] = tokG[i]; }
        __syncthreads();
    }
}

__device__ __forceinline__ int build_units(Frame& F, int l, int NT) {
    LAS int* list = (LAS int*)(F.lds + ULIST_OFF);
    gu32* gcnt = F.ctl + CW_CNT + l * 64;
    __syncthreads();
    int nU = 0;
    {
        int tot = 0; for (int e = 0; e < NEXP; ++e) { const int c = (int)__hip_atomic_load(gcnt + e, RLX_AGENT); tot += ((c + 255) >> 8) * NT; }
        nU = (tot > F.vcu) ? (tot - F.vcu + F.G - 1) / F.G : 0; if (nU > 64) nU = 64;
        if (F.tid < nU) { const int q = F.tid * F.G + F.vcu; int base = 0, blk0 = 0, e = 0, c = 0, nb = 0;
            for (e = 0; e < NEXP; ++e) { c = (int)__hip_atomic_load(gcnt + e, RLX_AGENT); nb = (c + 255) >> 8; if (q < base + nb * NT) break; base += nb * NT; blk0 += nb; }
            const int lq = q - base, rg = lq / (8 * NT), l2 = lq % (8 * NT), gsz = (nb - 8 * rg) < 8 ? (nb - 8 * rg) : 8, pn = l2 / gsz, rb = 8 * rg + l2 % gsz;
            list[F.tid * 8 + 0] = blk0 + rb; list[F.tid * 8 + 1] = e * NT + pn; list[F.tid * 8 + 2] = e; list[F.tid * 8 + 3] = rb; list[F.tid * 8 + 4] = c; }
    }
    __syncthreads();
    return nU;
}

__device__ __forceinline__ void p7_combine(Frame& F, int l) {
    const int gw = F.vcu * NWAVES + F.wave, NGW = F.G * NWAVES;
    const bf16* y4 = (const bf16*)(F.ws + WS_Y4); bf16* HB = (bf16*)(F.ws + WS_HB);
    for (int m = gw; m < M; m += NGW) { f32x4 v[4]; float* hr = F.H + (size_t)m * D;
#pragma unroll
        for (int j = 0; j < 4; ++j) v[j] = *(const f32x4*)(hr + 4 * F.lane + 256 * j) * ALPHA;
#pragma unroll
        for (int k = 0; k < 4; ++k) { const bf16* yr = y4 + ((size_t)m * 4 + k) * D;
#pragma unroll
            for (int j = 0; j < 4; ++j) { const v2u w = *(const v2u*)(yr + 4 * F.lane + 256 * j); v[j].x += bflo(w.x); v[j].y += bfhi(w.x); v[j].z += bflo(w.y); v[j].w += bfhi(w.y); } }
        ln_row(v, inp(F, 19) + l * D, inp(F, 20) + l * D, F.lane); store_row(v, hr, HB + (size_t)m * D, F.lane); }
}

struct Args { const float* in[21]; float* out; unsigned char* ws; int ph_lo, ph_hi; };
constexpr int N_PHASES = 1 + 7 * DEPTH;
__global__ void __launch_bounds__(NWAVES * 64, 2) fwd_kernel(Args args) {
    extern __shared__ __attribute__((aligned(16))) unsigned char lds[];
    Frame F;
    F.lds = (LAS unsigned char*)lds;
    F.MISC = (volatile LAS unsigned*)(F.lds + MISC_OFF);
    F.tid = threadIdx.x; F.lane = F.tid & 63; F.wave = __builtin_amdgcn_readfirstlane(F.tid >> 6);
    F.G = gridDim.x; { const int bx = blockIdx.x; F.vcu = (F.G % 8 == 0) ? (bx % 8) * (F.G / 8) + bx / 8 : bx; }
    F.ws = args.ws; F.ctl = (gu32*)(args.ws + WS_CTL); F.H = args.out;
    F.ka = (const __attribute__((address_space(4))) unsigned char*)__builtin_amdgcn_kernarg_segment_ptr();
    for (int u = F.tid; u < 64; u += NWAVES * 64) ((LAS unsigned*)(F.lds + MISC_OFF))[u] = 0u;
    __syncthreads();
#if MK_ONE_LAUNCH
    XcdBarrier bar = xcd_barrier_post((unsigned*)(F.ctl + CW_BAR), F.MISC + 8);
#define GRID_BAR() xcd_barrier(bar)
#else
#define GRID_BAR() do {} while (0)
#endif
    const int lo = args.ph_lo, hi = args.ph_hi;
#ifndef PH_MASK
#define PH_MASK 0xff
#endif
#define IN(k) (lo <= (k) && (k) < hi)
#define PHON(j) ((PH_MASK >> (j)) & 1)
#define OPQ(p) do { unsigned _lo = (unsigned)(uintptr_t)(p), _hi = (unsigned)((uintptr_t)(p) >> 32); asm volatile("" : "+v"(_lo), "+v"(_hi)); _lo = __builtin_amdgcn_readfirstlane(_lo); _hi = __builtin_amdgcn_readfirstlane(_hi); \
        (p) = (decltype(p))(((uintptr_t)_hi << 32) | _lo); } while (0)
#define REFRESH() do { OPQ(F.ka); OPQ(F.ws); OPQ(F.H); asm volatile("" : "+v"(F.tid)); F.lane = F.tid & 63; F.wave = __builtin_amdgcn_readfirstlane(F.tid >> 6); F.ctl = (gu32*)(F.ws + WS_CTL); F.lds = (LAS unsigned char*)lds; } while (0)
    if (PHON(0) && IN(0)) { REFRESH(); p0_prologue(F); GRID_BAR(); }
#pragma unroll 1
    for (int l = 0; l < DEPTH; ++l) {
        const int pb = 1 + 7 * l;
        if (PHON(1) && IN(pb + 0)) { REFRESH();
            pg8::Gemm g{(const bf16*)(F.ws + WS_HB), w_in_t(F, l), D}; pg8::StaticOrder S; S.init(M, NPROJ_PAD, F.G, (int)blockIdx.x);
            pg8::EpiProj E{(bf16*)(F.ws + WS_PROJ), NPROJ_PAD};
            pg8::gemm_phase<pg8::EpiProj, pg8::StaticOrder, false>(F.lds, g, S, E);
            GRID_BAR();
        }
        if (PHON(2) && IN(pb + 1)) { REFRESH(); p2_scan(F, l); GRID_BAR(); }
        if (PHON(3) && IN(pb + 2)) { REFRESH();
            pg8::Gemm g{(const bf16*)(F.ws + WS_Y), w_out_t(F, l), D}; pg8::StaticOrder S; S.init(M, D, F.G, (int)blockIdx.x);
            pg8::EpiResid E{F.H, ALPHA};
            pg8::gemm_phase<pg8::EpiResid, pg8::StaticOrder, false>(F.lds, g, S, E);
            GRID_BAR();
        }
        if (PHON(4) && IN(pb + 3)) { REFRESH(); p4_ln_router(F, l); GRID_BAR(); }
        if (PHON(5) && IN(pb + 4)) { REFRESH();
            const int nU = build_units(F, l, 8);
            pg8::Gemm g{(const bf16*)(F.ws + WS_HB), w_gu_t(F, l), D};
            pg8::ListOrder S{(const LAS int*)(F.lds + ULIST_OFF), nU, (const int*)(F.ws + WS_SLOT), CAP};
            pg8::EpiSwiglu E{(bf16*)(F.ws + WS_ACT), inp(F, 16) + (size_t)l * NEXP * 2048};
            pg8::gemm_phase<pg8::EpiSwiglu, pg8::ListOrder, true>(F.lds, g, S, E);
            GRID_BAR();
        }
        if (PHON(6) && IN(pb + 5)) { REFRESH();
            const int nU = build_units(F, l, 4);
            pg8::Gemm g{(const bf16*)(F.ws + WS_ACT), w_dn_t(F, l), DFF};
            pg8::ListOrder S{(const LAS int*)(F.lds + ULIST_OFF), nU, (const int*)(F.ws + WS_SLOT), CAP};
            pg8::EpiDown E{(bf16*)(F.ws + WS_Y4), inp(F, 18) + (size_t)l * NEXP * D, (const int*)(F.ws + WS_SLOT), (const float*)(F.ws + WS_SLOT + 8 * MiB), CAP};
            pg8::gemm_phase<pg8::EpiDown, pg8::ListOrder, false>(F.lds, g, S, E);
            GRID_BAR();
        }
        if (PHON(7) && IN(pb + 6)) { REFRESH(); p7_combine(F, l); if (l + 1 < DEPTH) GRID_BAR(); }
    }
#undef IN
}

extern "C" void kernel_launch(void* const* d_in, const int* in_sizes, int n_in, void* d_out, int out_size, void* d_ws, size_t ws_size, hipStream_t stream) {
    static int grid = 0;
    if (grid == 0) {
        if (n_in != 21 || in_sizes[0] != M * D || out_size != M * D || ws_size < WS_END) { fprintf(stderr, "kernel_launch: unexpected shapes (n_in %d, in0 %d, out %d, ws %zu)\n", n_in, n_in > 0 ? in_sizes[0] : -1, out_size, ws_size); grid = -1; return; }
        int dev = 0, cus = 0, per_cu = 0;
        if (hipGetDevice(&dev) != hipSuccess || hipDeviceGetAttribute(&cus, hipDeviceAttributeMultiprocessorCount, dev) != hipSuccess) { grid = -1; return; }
        if (hipFuncSetAttribute((const void*)fwd_kernel, hipFuncAttributeMaxDynamicSharedMemorySize, LDS_BYTES) != hipSuccess) { fprintf(stderr, "kernel_launch: hipFuncSetAttribute failed\n"); grid = -1; return; }
        if (hipOccupancyMaxActiveBlocksPerMultiprocessor(&per_cu, (const void*)fwd_kernel, NWAVES * 64, LDS_BYTES) != hipSuccess || per_cu < 1) fprintf(stderr, "kernel_launch: occupancy query says %d\n", per_cu);
        (void)hipGetLastError();
        grid = cus;
    }
    if (grid < 0) return;
    if (hipMemsetAsync((char*)d_ws + WS_CTL, 0, CTL_ZERO_BYTES, stream) != hipSuccess) return;
    Args a{};
    for (int i = 0; i < 21; ++i) a.in[i] = (const float*)d_in[i];
    a.out = (float*)d_out; a.ws = (unsigned char*)d_ws;
#if MK_ONE_LAUNCH
    a.ph_lo = 0; a.ph_hi = N_PHASES;
    hipLaunchKernelGGL(fwd_kernel, dim3(grid), dim3(NWAVES * 64), LDS_BYTES, stream, a);
#else
    for (int p = 0; p < N_PHASES; ++p) { a.ph_lo = p; a.ph_hi = p + 1; hipLaunchKernelGGL(fwd_kernel, dim3(grid), dim3(NWAVES * 64), LDS_BYTES, stream, a); }
#endif
}
```

```cpp
#include <hip/hip_runtime.h>
#include <cstdio>
#include <cstdint>

#ifndef CONV_GLA_CHUNKS
#define CONV_GLA_CHUNKS 768
#endif
#ifndef MK_ONE_LAUNCH
#define MK_ONE_LAUNCH 1
#endif

#define GAS __attribute__((address_space(1)))
#define LAS __attribute__((address_space(3)))
namespace pg8 {
#define PG8_LAS __attribute__((address_space(3)))
typedef unsigned short bf16_t;
typedef short bf16x8 __attribute__((ext_vector_type(8)));
typedef float f32x4 __attribute__((ext_vector_type(4)));
typedef unsigned u32x4 __attribute__((ext_vector_type(4)));
typedef int i32x4 __attribute__((ext_vector_type(4)));
constexpr int BM = 256, BK = 64, HALF = 128, HTB = HALF * BK * 2, STAGE_BYTES = 8 * HTB, NXCD = 8, WGM = 8;

__host__ __device__ __forceinline__ int lds_byte(int r, int c) { const int st = (r >> 4) * 2 + (c >> 5), rr = r & 15, cc = c & 31, ob = rr * 64 + cc * 2; return st * 1024 + (ob ^ (((ob >> 9) & 1) << 5)); }
__host__ __device__ __forceinline__ void stage_rc(int b, int& R, int& C) { const int st = b / 1024, sb = b % 1024, swz = sb ^ (((sb >> 9) & 1) << 5); R = (st >> 1) * 16 + swz / 64; C = (st & 1) * 32 + (swz % 64) / 2; }
__host__ __device__ __forceinline__ int perm32(int rho) { const int n = rho >> 4, i = rho & 15; return 8 * (i >> 2) + 4 * n + (i & 3); }

struct Unit { int pm, pn, e, rb, cnt; };
struct Gemm { const bf16_t* A; const bf16_t* Bt; int K; };

struct StaticOrder {
    int nM, nN, nwg, G, c;
    __device__ void init(int M, int N, int G_, int c_) { nM = M / BM; nN = N / BM; nwg = nM * nN; G = G_; c = c_; }
    __device__ __forceinline__ bool next(int i, Unit& u) const {
        const long L = (long)i * G + c; if (L >= nwg) return false;
        int wgid = (int)L; { const int q = nwg / NXCD, r = nwg % NXCD, xcd = wgid % NXCD, off = wgid / NXCD; wgid = (xcd < r ? xcd * (q + 1) : r * (q + 1) + (xcd - r) * q) + off; }
        const int nig = WGM * nN, gid = wgid / nig, fm = gid * WGM, gsz = (nM - fm) < WGM ? (nM - fm) : WGM;
        u.pm = fm + ((wgid % nig) % gsz); u.pn = (wgid % nig) / gsz; u.e = 0; u.rb = 0; u.cnt = 0; return true;
    }
    __device__ __forceinline__ unsigned row_off(const Unit&, int, int) const { return 0u; }
    __device__ __forceinline__ const int* gsrc() const { return nullptr; }
    __device__ __forceinline__ unsigned gsoff(const Unit&) const { return 0u; }
    __device__ __forceinline__ unsigned raw_off(const Unit&, int, int, unsigned) const { return 0u; }
};
struct ListOrder {
    const PG8_LAS int* list; int n;
    const GAS int* slot_dst; int cap; unsigned rowbytes;
    __device__ __forceinline__ bool next(int i, Unit& u) const {
        if (i >= n) return false;
        const PG8_LAS int* p = list + i * 8;
        u.pm = __builtin_amdgcn_readfirstlane(p[0]); u.pn = __builtin_amdgcn_readfirstlane(p[1]); u.e = __builtin_amdgcn_readfirstlane(p[2]);
        u.rb = __builtin_amdgcn_readfirstlane(p[3]); u.cnt = __builtin_amdgcn_readfirstlane(p[4]); return true;
    }
    __device__ __forceinline__ unsigned row_off(const Unit& u, int h, int R) const {
        const int pos = u.rb * 256 + h * 128 + R;
        int tok = 0; if (pos < u.cnt) tok = slot_dst[(size_t)u.e * cap + pos] >> 2;
        return (unsigned)tok * rowbytes;
    }
    __device__ __forceinline__ const int* gsrc() const { return (const int*)slot_dst; }
    __device__ __forceinline__ unsigned gsoff(const Unit& u) const { return (unsigned)u.e * (unsigned)cap * 4u; }
    __device__ __forceinline__ unsigned raw_off(const Unit& u, int h, int R, unsigned raw) const { const int pos = u.rb * 256 + h * 128 + R; return (pos < u.cnt ? (raw >> 2) : 0u) * rowbytes; }
};

typedef float f32x2c __attribute__((ext_vector_type(2)));
typedef __bf16 bf16x2c __attribute__((ext_vector_type(2)));
__device__ __forceinline__ unsigned cvt_pk_bf16(float lo, float hi) { const f32x2c v = {lo, hi}; const bf16x2c b = __builtin_convertvector(v, bf16x2c); return __builtin_bit_cast(unsigned, b); }

struct Pre2 { unsigned a, b; };
__device__ __forceinline__ unsigned pack_i8x4(float x0, float x1, float x2, float x3) {
    const unsigned y0 = __float_as_uint(x0 + 12582912.0f), y1 = __float_as_uint(x1 + 12582912.0f), y2 = __float_as_uint(x2 + 12582912.0f), y3 = __float_as_uint(x3 + 12582912.0f);
    return (y0 & 0xffu) | ((y1 & 0xffu) << 8) | ((y2 & 0xffu) << 16) | (y3 << 24);
}
struct EpiProj {
    static constexpr bool PERM = true, HAS_PRE = true; static constexpr int NVM = 16; typedef Pre2 Pre;
    bf16_t* O; int ldc; const GAS float* hs; const GAS unsigned* cmax;
    __device__ __forceinline__ Pre2 prefetch(const Unit& u, int t) const { Pre2 p; p.b = 0u;
        p.a = t < 256 ? __float_as_uint(hs[u.pm * BM + t]) : cmax[u.pn * BM + (t - 256)]; return p; }
    __device__ __forceinline__ void stash(const Pre2& p, PG8_LAS unsigned* scr, int t) const { scr[t] = p.a; }
    __device__ __forceinline__ void operator()(const i32x4 (&acc)[2][2][4][2], const Unit& u, int wr, int wc, int fr, int fq, PG8_LAS unsigned* scr) const {
        const int row0 = u.pm * BM + wr * 64 + fr, col0 = u.pn * BM + wc * 32 + 8 * fq;
        f32x4 cs[2][2];
#pragma unroll
        for (int bj = 0; bj < 2; ++bj)
#pragma unroll
            for (int n = 0; n < 2; ++n) cs[bj][n] = *(const PG8_LAS f32x4*)(scr + 256 + bj * HALF + wc * 32 + 8 * fq + 4 * n) * (1.0f / 127.0f);
#pragma unroll
        for (int ai = 0; ai < 2; ++ai)
#pragma unroll
            for (int m = 0; m < 4; ++m) { const int r = ai * HALF + wr * 64 + m * 16 + fr; const float rs = __uint_as_float(scr[r]); bf16_t* rowp = O + (size_t)(u.pm * BM + r) * ldc + col0;
#pragma unroll
                for (int bj = 0; bj < 2; ++bj) { const f32x4 v0 = __builtin_convertvector(acc[ai][bj][m][0], f32x4) * (cs[bj][0] * rs), v1 = __builtin_convertvector(acc[ai][bj][m][1], f32x4) * (cs[bj][1] * rs);
                    u32x4 w; w.x = cvt_pk_bf16(v0[0], v0[1]); w.y = cvt_pk_bf16(v0[2], v0[3]); w.z = cvt_pk_bf16(v1[0], v1[1]); w.w = cvt_pk_bf16(v1[2], v1[3]);
                    *(GAS u32x4*)(rowp + bj * HALF) = w; } }
        (void)row0;
    }
};
struct EpiMix {
    static constexpr bool PERM = true, HAS_PRE = false; static constexpr int NVM = 16; typedef Pre2 Pre;
    bf16_t* O;
    __device__ __forceinline__ Pre2 prefetch(const Unit&, int) const { return Pre2{0u, 0u}; }
    __device__ __forceinline__ void stash(const Pre2&, PG8_LAS unsigned*, int) const {}
    __device__ __forceinline__ void operator()(const f32x4 (&acc)[2][2][4][2], const Unit& u, int wr, int wc, int fr, int fq, PG8_LAS unsigned*) const {
        const int row0 = u.pm * BM + wr * 64 + fr, col0 = u.pn * BM + wc * 32 + 8 * fq;
#pragma unroll
        for (int ai = 0; ai < 2; ++ai)
#pragma unroll
            for (int m = 0; m < 4; ++m) { bf16_t* rowp = O + (size_t)(row0 + ai * HALF + m * 16) * 1024 + col0;
#pragma unroll
                for (int bj = 0; bj < 2; ++bj) { const f32x4 v0 = acc[ai][bj][m][0], v1 = acc[ai][bj][m][1];
                    u32x4 w; w.x = cvt_pk_bf16(v0[0], v0[1]); w.y = cvt_pk_bf16(v0[2], v0[3]); w.z = cvt_pk_bf16(v1[0], v1[1]); w.w = cvt_pk_bf16(v1[2], v1[3]);
                    *(GAS u32x4*)(rowp + bj * HALF) = w; } }
    }
};
constexpr float ACT_SC = 8.0f;
struct EpiSwiglu {
    static constexpr bool PERM = true, HAS_PRE = true; static constexpr int NVM = 4; typedef Pre2 Pre;
    unsigned char* act; const GAS float* bgu; const GAS float* slot_hs; const GAS unsigned* cmax; int cap;
    __device__ __forceinline__ Pre2 prefetch(const Unit& u, int t) const { Pre2 p; const int j = u.pn & 7;
        if (t < 256) { p.a = __float_as_uint(slot_hs[(size_t)u.e * cap + u.rb * 256 + t]); p.b = __float_as_uint(bgu[(size_t)u.e * 2048 + (t < 128 ? j * 128 + t : 1024 + j * 128 + (t - 128))]); }
        else { p.a = cmax[(size_t)u.e * 2048 + j * 256 + (t - 256)]; p.b = 0u; }
        return p; }
    __device__ __forceinline__ void stash(const Pre2& p, PG8_LAS unsigned* scr, int t) const { scr[t] = p.a; if (t < 256) scr[512 + t] = p.b; }
    __device__ __forceinline__ void operator()(const i32x4 (&acc)[2][2][4][2], const Unit& u, int wr, int wc, int fr, int fq, PG8_LAS unsigned* scr) const {
        const int j = u.pn & 7;
        const int row0 = u.pm * BM + wr * 64 + fr, c0 = j * 128 + wc * 32 + 8 * fq, cl = wc * 32 + 8 * fq;
        f32x4 bgv[2], buv[2], csg[2], csu[2];
        constexpr float C2 = 1.702f * 1.44269504f;
#pragma unroll
        for (int n = 0; n < 2; ++n) { bgv[n] = *(const PG8_LAS f32x4*)(scr + 512 + cl + 4 * n) * C2; buv[n] = *(const PG8_LAS f32x4*)(scr + 512 + 128 + cl + 4 * n);
            csg[n] = *(const PG8_LAS f32x4*)(scr + 256 + cl + 4 * n) * (C2 / 127.0f); csu[n] = *(const PG8_LAS f32x4*)(scr + 256 + 128 + cl + 4 * n) * (1.0f / 127.0f); }
#pragma unroll
        for (int ai = 0; ai < 2; ++ai)
#pragma unroll
            for (int mp = 0; mp < 4; mp += 2) { unsigned wp[2][2];
#pragma unroll
                for (int hm = 0; hm < 2; ++hm) { const int m = mp + hm; const int r = ai * HALF + wr * 64 + m * 16 + fr; const float rs = __uint_as_float(scr[r]); float o[8];
                    float hh[8], uu[8], ee[8];
#pragma unroll
                    for (int n = 0; n < 2; ++n) { const f32x4 sgr = csg[n] * rs, sur = csu[n] * rs;
#pragma unroll
                        for (int q = 0; q < 4; ++q) { hh[4 * n + q] = fminf(__builtin_fmaf((float)acc[ai][0][m][n][q], sgr[q], bgv[n][q]), 7.0f * C2); uu[4 * n + q] = fminf(fmaxf(__builtin_fmaf((float)acc[ai][1][m][n][q], sur[q], buv[n][q]), -7.0f), 7.0f); } }
#pragma unroll
                    for (int i = 0; i < 8; ++i) ee[i] = __builtin_amdgcn_exp2f(-hh[i]);
#pragma unroll
                    for (int i = 0; i < 8; ++i) ee[i] = __builtin_amdgcn_rcpf(1.0f + ee[i]);
#pragma unroll
                    for (int i = 0; i < 8; ++i) o[i] = __builtin_fmaf(uu[i], ACT_SC / C2, ACT_SC / C2) * (hh[i] * ee[i]);
                    int w0 = __builtin_amdgcn_cvt_pk_fp8_f32(o[0], o[1], 0, false); w0 = __builtin_amdgcn_cvt_pk_fp8_f32(o[2], o[3], w0, true);
                    int w1 = __builtin_amdgcn_cvt_pk_fp8_f32(o[4], o[5], 0, false); w1 = __builtin_amdgcn_cvt_pk_fp8_f32(o[6], o[7], w1, true);
                    wp[hm][0] = (unsigned)w0; wp[hm][1] = (unsigned)w1; }
                { auto r0 = __builtin_amdgcn_permlane16_swap(wp[0][0], wp[1][0], false, false); wp[0][0] = r0[0]; wp[1][0] = r0[1];
                  auto r1 = __builtin_amdgcn_permlane16_swap(wp[0][1], wp[1][1], false, false); wp[0][1] = r1[0]; wp[1][1] = r1[1]; }
                const int odd = fq & 1;
                const size_t arow = (size_t)(row0 + ai * HALF + (mp + odd) * 16);
                *(GAS u32x4*)(act + arow * 1024 + (c0 - 8 * odd)) = (u32x4){wp[0][0], wp[0][1], wp[1][0], wp[1][1]};
                __builtin_amdgcn_sched_barrier(0); }
    }
};
struct Pre3 { unsigned a, b, c; };
constexpr float WDN_SC = 447.0f;
struct EpiDown {
    static constexpr bool PERM = true, HAS_PRE = true; static constexpr int NVM = 8; typedef Pre3 Pre;
    bf16_t* y4; int trash; const GAS float* bdn; const GAS int* slot_dst; const GAS float* slot_gate; const GAS unsigned* cmax; int cap;
    __device__ __forceinline__ Pre3 prefetch(const Unit& u, int t) const { Pre3 p;
        if (t < 256) { const size_t si = (size_t)u.e * cap + u.rb * 256 + t; p.a = (unsigned)slot_dst[si]; p.b = __float_as_uint(slot_gate[si]); p.c = 0u; }
        else { p.a = __float_as_uint(bdn[(size_t)u.e * 1024 + (u.pn & 3) * 256 + (t - 256)]); p.b = cmax[(size_t)u.e * 1024 + (u.pn & 3) * 256 + (t - 256)]; p.c = 0u; }
        return p; }
    __device__ __forceinline__ void stash(const Pre3& p, PG8_LAS unsigned* scr, int t) const { scr[t] = p.a; scr[512 + t] = p.b; }
    __device__ __forceinline__ void operator()(const f32x4 (&acc)[2][2][4][2], const Unit& u, int wr, int wc, int fr, int fq, PG8_LAS unsigned* scr) const {
        const int jn = u.pn & 3;
        const int c0 = jn * 256 + wc * 32 + 8 * fq, cl = wc * 32 + 8 * fq;
        f32x4 bv[2][2], cs[2][2];
#pragma unroll
        for (int bj = 0; bj < 2; ++bj)
#pragma unroll
            for (int n = 0; n < 2; ++n) { bv[bj][n] = *(const PG8_LAS f32x4*)(scr + 256 + bj * HALF + cl + 4 * n); cs[bj][n] = *(const PG8_LAS f32x4*)(scr + 768 + bj * HALF + cl + 4 * n) * (1.0f / (WDN_SC * ACT_SC)); }
#pragma unroll
        for (int ai = 0; ai < 2; ++ai)
#pragma unroll
            for (int mp = 0; mp < 4; mp += 2) { unsigned wq[2][2][2]; int dsts[2];
#pragma unroll
                for (int hm = 0; hm < 2; ++hm) { const int m = mp + hm; const int r = ai * HALF + wr * 64 + m * 16 + fr; const int pos = u.rb * 256 + r;
                    dsts[hm] = pos < u.cnt ? (int)scr[r] : trash + r; const float rg = __uint_as_float(scr[512 + r]) * 16.0f;
#pragma unroll
                    for (int bj = 0; bj < 2; ++bj) { f32x4 v0 = (acc[ai][bj][m][0] * cs[bj][0] + bv[bj][0]) * rg, v1 = (acc[ai][bj][m][1] * cs[bj][1] + bv[bj][1]) * rg;
#pragma unroll
                        for (int q = 0; q < 4; ++q) { v0[q] = fminf(fmaxf(v0[q], -448.0f), 448.0f); v1[q] = fminf(fmaxf(v1[q], -448.0f), 448.0f); }
                        int w0 = __builtin_amdgcn_cvt_pk_fp8_f32(v0[0], v0[1], 0, false); w0 = __builtin_amdgcn_cvt_pk_fp8_f32(v0[2], v0[3], w0, true);
                        int w1 = __builtin_amdgcn_cvt_pk_fp8_f32(v1[0], v1[1], 0, false); w1 = __builtin_amdgcn_cvt_pk_fp8_f32(v1[2], v1[3], w1, true);
                        wq[hm][bj][0] = (unsigned)w0; wq[hm][bj][1] = (unsigned)w1; } }
                const int odd = fq & 1; unsigned char* rowp = (unsigned char*)y4 + (size_t)(odd ? dsts[1] : dsts[0]) * 1024 + (c0 - 8 * odd);
#pragma unroll
                for (int bj = 0; bj < 2; ++bj) {
                    auto r0 = __builtin_amdgcn_permlane16_swap(wq[0][bj][0], wq[1][bj][0], false, false); auto r1 = __builtin_amdgcn_permlane16_swap(wq[0][bj][1], wq[1][bj][1], false, false);
                    *(GAS u32x4*)(rowp + bj * HALF) = (u32x4){(unsigned)r0[0], (unsigned)r1[0], (unsigned)r0[1], (unsigned)r1[1]}; } }
    }
};

template <int MODE> struct AccOf { typedef f32x4 type; };
template <> struct AccOf<1> { typedef i32x4 type; };
__device__ __forceinline__ f32x4 mma16(bf16x8 a, bf16x8 b, f32x4 c) { asm volatile("v_mfma_f32_16x16x32_bf16 %0, %1, %2, %0" : "+v"(c) : "v"(a), "v"(b)); return c; }
__device__ __forceinline__ i32x4 mma16(bf16x8 a, bf16x8 b, i32x4 c) { asm volatile("v_mfma_i32_16x16x64_i8 %0, %1, %2, %0" : "+v"(c) : "v"(a), "v"(b)); return c; }
typedef int i32x8 __attribute__((ext_vector_type(8)));
__device__ __forceinline__ f32x4 mma128(bf16x8 a0, bf16x8 a1, bf16x8 b0, bf16x8 b1, f32x4 c) {
    const i32x8 a = __builtin_shufflevector(__builtin_bit_cast(i32x4, a0), __builtin_bit_cast(i32x4, a1), 0, 1, 2, 3, 4, 5, 6, 7), b = __builtin_shufflevector(__builtin_bit_cast(i32x4, b0), __builtin_bit_cast(i32x4, b1), 0, 1, 2, 3, 4, 5, 6, 7);
    asm volatile("v_mfma_f32_16x16x128_f8f6f4 %0, %1, %2, %0" : "+v"(c) : "v"(a), "v"(b)); return c;
}
__device__ __forceinline__ f32x4 mma16z(bf16x8 a, bf16x8 b, f32x4) { f32x4 c; asm volatile("v_mfma_f32_16x16x32_bf16 %0, %1, %2, 0" : "=&v"(c) : "v"(a), "v"(b)); return c; }
__device__ __forceinline__ i32x4 mma16z(bf16x8 a, bf16x8 b, i32x4) { i32x4 c; asm volatile("v_mfma_i32_16x16x64_i8 %0, %1, %2, 0" : "=&v"(c) : "v"(a), "v"(b)); return c; }
__device__ __forceinline__ f32x4 mma128z(bf16x8 a0, bf16x8 a1, bf16x8 b0, bf16x8 b1) {
    const i32x8 a = __builtin_shufflevector(__builtin_bit_cast(i32x4, a0), __builtin_bit_cast(i32x4, a1), 0, 1, 2, 3, 4, 5, 6, 7), b = __builtin_shufflevector(__builtin_bit_cast(i32x4, b0), __builtin_bit_cast(i32x4, b1), 0, 1, 2, 3, 4, 5, 6, 7);
    f32x4 c; asm volatile("v_mfma_f32_16x16x128_f8f6f4 %0, %1, %2, 0" : "=&v"(c) : "v"(a), "v"(b)); return c;
}
template <class Epi, class Sched, bool GATHER, int MODE>
__device__ __forceinline__ void gemm_phase(PG8_LAS unsigned char* lds, PG8_LAS unsigned* scr, const Gemm g, const Sched& S, const Epi& E, int tid_in) {
    int tid = tid_in; asm volatile("" : "+v"(tid));
    const int wid = __builtin_amdgcn_readfirstlane(tid >> 6), lane = tid & 63, wr = wid >> 2, wc = wid & 3, fr = lane & 15, fq = lane >> 4;
    constexpr int K = MODE ? 512 : 1024, nt = K / BK;
    unsigned voffA[2], voffB[2];
#pragma unroll
    for (int i = 0; i < 2; ++i) { int R, C; stage_rc(tid * 16 + i * 8192, R, C); const int Rb = Epi::PERM ? ((R & ~31) + perm32(R & 31)) : R;
        voffA[i] = (unsigned)(R * K + C) * 2u; voffB[i] = (unsigned)(Rb * K + C) * 2u; }
    auto gather4 = [&](const Unit& uu) { u32x4 o; int tz = tid; asm volatile("" : "+v"(tz));
#pragma unroll
        for (int i = 0; i < 2; ++i) { int R, C; stage_rc(tz * 16 + i * 8192, R, C); o[i] = S.row_off(uu, 0, R) + (unsigned)C * 2u; o[2 + i] = S.row_off(uu, 1, R) + (unsigned)C * 2u; }
        return o; };
    auto gather_issue = [&](const Unit& uu) { int tz = tid; asm volatile("" : "+v"(tz));
        const __amdgpu_buffer_rsrc_t rs = __builtin_amdgcn_make_buffer_rsrc((void*)S.gsrc(), 0, (int)0xFFFFFFFFu, 0x00020000); const unsigned so = S.gsoff(uu);
#pragma unroll
        for (int i = 0; i < 2; ++i) { int R, C; stage_rc(tz * 16 + i * 8192, R, C);
#pragma unroll
            for (int h = 0; h < 2; ++h) __builtin_amdgcn_raw_ptr_buffer_load_lds(rs, (PG8_LAS void*)((PG8_LAS unsigned char*)(scr + 1024) + (2 * h + i) * 2048 + wid * 256), 4, (int)((unsigned)(uu.rb * 256 + h * 128 + R) * 4u), (int)so, 0, 0); } };
    auto gather_read = [&](const Unit& uu) { u32x4 o; int tz = tid; asm volatile("" : "+v"(tz));
#pragma unroll
        for (int i = 0; i < 2; ++i) { int R, C; stage_rc(tz * 16 + i * 8192, R, C);
#pragma unroll
            for (int h = 0; h < 2; ++h) o[2 * h + i] = S.raw_off(uu, h, R, *((const PG8_LAS unsigned*)(scr + 1024) + (2 * h + i) * 512 + tz)) + (unsigned)C * 2u; }
        return o; };
    constexpr unsigned kstep = (unsigned)(BK * 2);
    constexpr unsigned hstep = (unsigned)HALF * K * 2;
    constexpr unsigned tstep = 2 * hstep;
    constexpr unsigned hstepA = GATHER ? 0u : hstep;
    const __amdgpu_buffer_rsrc_t baseA = __builtin_amdgcn_make_buffer_rsrc((void*)g.A, 0, (int)0xFFFFFFFFu, 0x00020000), baseB = __builtin_amdgcn_make_buffer_rsrc((void*)g.Bt, 0, (int)0xFFFFFFFFu, 0x00020000);
    const unsigned ldsw = (unsigned)wid * 1024u;
    const int aoff = lds_byte(wr * 64 + fr, fq * 8), boff = lds_byte(wc * 32 + fr, fq * 8);
#define PG8_SA(b, h) (((b) * 2 + (h)) * HTB)
#define PG8_SB(b, h) ((4 + (b) * 2 + (h)) * HTB)
#define PG8_STAGE(bufoff, base, uoff, voff) do { _Pragma("unroll") for (int _i = 0; _i < 2; ++_i) \
        __builtin_amdgcn_raw_ptr_buffer_load_lds((base), (PG8_LAS void*)(lds + (bufoff) + ldsw + _i * 8192), 16, (int)(voff)[_i], (int)(uoff), 0, 0); } while (0)
#define PG8_LDA(dst, b, h) do { _Pragma("unroll") for (int m = 0; m < 4; ++m) _Pragma("unroll") for (int k = 0; k < 2; ++k) dst[m][k] = *(const PG8_LAS bf16x8*)(lds + PG8_SA(b, h) + aoff + m * 2048 + k * 1024); } while (0)
#define PG8_LDB(dst, b, h) do { _Pragma("unroll") for (int n = 0; n < 2; ++n) _Pragma("unroll") for (int k = 0; k < 2; ++k) dst[n][k] = *(const PG8_LAS bf16x8*)(lds + PG8_SB(b, h) + boff + n * 2048 + k * 1024); } while (0)
#define PG8_MMA(ai, bj, At, Bt) do { __builtin_amdgcn_s_setprio(1); _Pragma("unroll") for (int m = 0; m < 4; ++m) _Pragma("unroll") for (int n = 0; n < 2; ++n) { \
        if constexpr (MODE == 2) acc[ai][bj][m][n] = mma128(Bt[n][0], Bt[n][1], At[m][0], At[m][1], acc[ai][bj][m][n]); \
        else { _Pragma("unroll") for (int k = 0; k < 2; ++k) acc[ai][bj][m][n] = mma16(Bt[n][k], At[m][k], acc[ai][bj][m][n]); } } __builtin_amdgcn_s_setprio(0); } while (0)
#define PG8_MMAZ(ai, bj, At, Bt) do { __builtin_amdgcn_s_setprio(1); _Pragma("unroll") for (int m = 0; m < 4; ++m) _Pragma("unroll") for (int n = 0; n < 2; ++n) { \
        if constexpr (MODE == 2) acc[ai][bj][m][n] = mma128z(Bt[n][0], Bt[n][1], At[m][0], At[m][1]); \
        else { acc[ai][bj][m][n] = mma16z(Bt[n][0], At[m][0], acc[ai][bj][m][n]); acc[ai][bj][m][n] = mma16(Bt[n][1], At[m][1], acc[ai][bj][m][n]); } } __builtin_amdgcn_s_setprio(0); } while (0)
#define PG8_WAIT_V(n) asm volatile("s_waitcnt vmcnt(" #n ")" ::: "memory")
#define PG8_WAIT_VN(n) asm volatile("s_waitcnt vmcnt(%0)" :: "n"(n) : "memory")
#define PG8_WAIT_L(n) asm volatile("s_waitcnt lgkmcnt(" #n ")" ::: "memory")
#define PG8_BAR __builtin_amdgcn_s_barrier()
#define PG8_SCHED __builtin_amdgcn_sched_barrier(0)
    Unit cur, nxt; int ui = 0;
    if (!S.next(0, cur)) return;
    typedef typename AccOf<MODE>::type AccT;
    AccT acc[2][2][4][2];
    bf16x8 At[4][2], B0[2][2], B1[2][2];
    unsigned c0[2], c1[2];
    if (GATHER) { gather_issue(cur); asm volatile("s_waitcnt vmcnt(0)" ::: "memory");
        const u32x4 o = gather_read(cur); c0[0] = o[0]; c0[1] = o[1]; c1[0] = o[2]; c1[1] = o[3]; }
    else { c0[0] = voffA[0]; c0[1] = voffA[1]; c1[0] = voffA[0]; c1[1] = voffA[1]; }
    unsigned cA = GATHER ? 0u : (unsigned)cur.pm * tstep, cB = (unsigned)cur.pn * tstep;
    PG8_STAGE(PG8_SB(0, 0), baseB, cB, voffB); PG8_STAGE(PG8_SB(0, 1), baseB, cB + hstep, voffB); PG8_STAGE(PG8_SA(0, 0), baseA, cA, c0); PG8_STAGE(PG8_SA(0, 1), baseA, cA + hstepA, c1);
    if (wr == 1) PG8_BAR;
    PG8_WAIT_V(2); PG8_BAR;
    PG8_STAGE(PG8_SB(1, 0), baseB, cB + kstep, voffB); PG8_STAGE(PG8_SA(1, 0), baseA, cA + kstep, c0); PG8_STAGE(PG8_SB(1, 1), baseB, cB + hstep + kstep, voffB);
    PG8_WAIT_V(6); PG8_BAR;
    for (;;) {
        const typename Epi::Pre pre = E.prefetch(cur, tid);
        const bool has_next = S.next(ui + 1, nxt);
        const unsigned nA = has_next ? (GATHER ? 0u : (unsigned)nxt.pm * tstep) : cA, nB = has_next ? (unsigned)nxt.pn * tstep : cB;
        if (GATHER && has_next) gather_issue(nxt);
        {
            const unsigned a1 = cA + kstep, a2 = cA + 2u * kstep, b2 = cB + 2u * kstep, a3 = a2 + kstep, b3 = b2 + kstep;
            PG8_LDB(B0, 0, 0); PG8_LDB(B1, 0, 1); PG8_SCHED; PG8_LDA(At, 0, 0); PG8_STAGE(PG8_SA(1, 1), baseA, a1 + hstepA, c1);
            if (ui > 0) PG8_WAIT_VN(8 + Epi::NVM); else PG8_WAIT_V(8);
            PG8_WAIT_L(0); PG8_BAR; PG8_MMAZ(0, 0, At, B0); PG8_MMAZ(0, 1, At, B1); PG8_BAR; PG8_SCHED;
            PG8_LDA(At, 0, 1); PG8_STAGE(PG8_SB(0, 0), baseB, b2, voffB); PG8_STAGE(PG8_SB(0, 1), baseB, b2 + hstep, voffB); PG8_STAGE(PG8_SA(0, 0), baseA, a2, c0);
            if (ui > 0) PG8_WAIT_VN(8 + Epi::NVM); else PG8_WAIT_V(8);
            PG8_WAIT_L(0); PG8_BAR; PG8_MMAZ(1, 0, At, B0); PG8_MMAZ(1, 1, At, B1); PG8_BAR; PG8_SCHED;
            PG8_LDB(B0, 1, 0); PG8_LDB(B1, 1, 1); PG8_SCHED; PG8_LDA(At, 1, 0); PG8_STAGE(PG8_SA(0, 1), baseA, a2 + hstepA, c1);
            PG8_WAIT_V(8); PG8_WAIT_L(0); PG8_BAR; PG8_MMA(0, 0, At, B0); PG8_MMA(0, 1, At, B1); PG8_BAR; PG8_SCHED;
            PG8_LDA(At, 1, 1); PG8_STAGE(PG8_SB(1, 0), baseB, b3, voffB); PG8_STAGE(PG8_SB(1, 1), baseB, b3 + hstep, voffB); PG8_STAGE(PG8_SA(1, 0), baseA, a3, c0);
            PG8_WAIT_V(8); PG8_WAIT_L(0); PG8_BAR; PG8_MMA(1, 0, At, B0); PG8_MMA(1, 1, At, B1); PG8_BAR; PG8_SCHED;
        }
#pragma unroll 1
        for (int t = 2; t < nt; t += 2) {
            const bool last = (t == nt - 2);
            const int tt = __builtin_amdgcn_readfirstlane(t);
            const unsigned a1 = cA + (unsigned)(tt + 1) * kstep;
            const unsigned a2 = last ? nA : cA + (unsigned)(tt + 2) * kstep, b2 = last ? nB : cB + (unsigned)(tt + 2) * kstep;
            const unsigned a3 = a2 + kstep, b3 = b2 + kstep;
            unsigned s0[2], s1[2];
            if (GATHER && last && has_next) { const u32x4 nx = gather_read(nxt); s0[0] = nx[0]; s0[1] = nx[1]; s1[0] = nx[2]; s1[1] = nx[3]; }
            else { s0[0] = c0[0]; s0[1] = c0[1]; s1[0] = c1[0]; s1[1] = c1[1]; }
            PG8_LDB(B0, 0, 0); PG8_LDB(B1, 0, 1); PG8_SCHED; PG8_LDA(At, 0, 0); PG8_STAGE(PG8_SA(1, 1), baseA, a1 + hstepA, c1);
            PG8_WAIT_V(8); PG8_WAIT_L(0); PG8_BAR; PG8_MMA(0, 0, At, B0); PG8_MMA(0, 1, At, B1); PG8_BAR; PG8_SCHED;
            PG8_LDA(At, 0, 1); PG8_STAGE(PG8_SB(0, 0), baseB, b2, voffB); PG8_STAGE(PG8_SB(0, 1), baseB, b2 + hstep, voffB); PG8_STAGE(PG8_SA(0, 0), baseA, a2, s0);
            PG8_WAIT_V(8); PG8_WAIT_L(0); PG8_BAR; PG8_MMA(1, 0, At, B0); PG8_MMA(1, 1, At, B1); PG8_BAR; PG8_SCHED;
            PG8_LDB(B0, 1, 0); PG8_LDB(B1, 1, 1); PG8_SCHED; PG8_LDA(At, 1, 0); PG8_STAGE(PG8_SA(0, 1), baseA, a2 + hstepA, s1);
            PG8_WAIT_V(8); PG8_WAIT_L(0); PG8_BAR; PG8_MMA(0, 0, At, B0); PG8_MMA(0, 1, At, B1); PG8_BAR; PG8_SCHED;
            PG8_LDA(At, 1, 1); PG8_STAGE(PG8_SB(1, 0), baseB, b3, voffB); PG8_STAGE(PG8_SB(1, 1), baseB, b3 + hstep, voffB); PG8_STAGE(PG8_SA(1, 0), baseA, a3, s0);
            PG8_WAIT_V(8); PG8_WAIT_L(0); PG8_BAR; PG8_MMA(1, 0, At, B0); PG8_MMA(1, 1, At, B1); PG8_BAR; PG8_SCHED;
        }
        asm volatile("s_nop 15\n\ts_nop 7" ::: "memory");
        if (wr == 0) PG8_BAR;
        if (Epi::HAS_PRE) { E.stash(pre, scr, tid); PG8_WAIT_L(0); PG8_BAR; }
        { int tz = tid; asm volatile("" : "+v"(tz));
          const int lz = tz & 63, wz = tz >> 6; E(acc, cur, wz >> 2, wz & 3, lz & 15, lz >> 4, scr); }
        if (!has_next) break;
        cur = nxt; cA = nA; cB = nB; ++ui;
        if (GATHER) { const u32x4 nx = gather_read(cur); c0[0] = nx[0]; c0[1] = nx[1]; c1[0] = nx[2]; c1[1] = nx[3]; }
        if (wr == 1) PG8_BAR;
    }
    PG8_WAIT_V(0);
    PG8_BAR;
#undef PG8_SA
#undef PG8_SB
#undef PG8_STAGE
#undef PG8_LDA
#undef PG8_LDB
#undef PG8_MMA
#undef PG8_MMAZ
#undef PG8_WAIT_V
#undef PG8_WAIT_VN
#undef PG8_WAIT_L
#undef PG8_BAR
#undef PG8_SCHED
}
}

constexpr int NWAVES = 8;
constexpr int BATCH = 32, SEQ = 2048, D = 1024, DEPTH = 2;
constexpr int M = BATCH * SEQ;
constexpr int NPROJ = 3344, NPROJ_PAD = 3584;
constexpr int NEXP = 32, TOPK = 4, DFF = 1024;
constexpr int CAP = M;
constexpr float LN_EPS = 1e-5f, RMS_EPS = 1e-6f;
constexpr float ALPHA = 1.4142135623730951f;
constexpr int C_GQ = 0, C_GK = 256, C_GV = 512, C_GLG = 1024, C_GOG = 1280, C_HQ = 1792, C_HF = 2048, C_HI = 2304, C_HOG = 2560, C_CB = 2816, C_CC = 3072, C_CH = 3328;
constexpr int SRC_GLR = 1024, GLR_RANK = 16;

constexpr size_t MiB = 1u << 20;
constexpr size_t WS_CTL = 0, CTL_ZERO_BYTES = 1 * MiB;
constexpr size_t W_IN_B = (size_t)NPROJ_PAD * D * 2, W_OUT_B = (size_t)D * D * 2, W_GU_B = (size_t)NEXP * 2048 * D * 2, W_DN_B = (size_t)NEXP * D * DFF * 2;
constexpr size_t W_LAYER_B = W_IN_B + W_OUT_B + W_GU_B + W_DN_B;
constexpr size_t WS_W = 2 * MiB;
constexpr size_t WS_HB = 404 * MiB;
constexpr size_t WS_R1 = 532 * MiB;
constexpr size_t WS_MIX = WS_R1, WS_PROJ = WS_R1 + 128 * MiB, WS_Y = WS_PROJ + 448 * MiB, WS_ACT = WS_PROJ;
constexpr size_t ACT_ROWS = (size_t)M * 4 + NEXP * 256;
static_assert(ACT_ROWS * 1024 <= 576 * MiB, "fp8 activations [ACT_ROWS][1024] fit the proj|Y overlay");
constexpr size_t WS_Y4 = 1236 * MiB;
constexpr size_t WS_SLOT = 1748 * MiB;
constexpr size_t WS_END = 1772 * MiB;
static_assert((size_t)(M * 4 + NEXP * 256) * 1024 * 2 <= 576 * MiB, "act fits the proj|Y region");
constexpr int CW_BAR = 4096;
constexpr int CW_CNT = 16384;
constexpr int CW_CMAX_IN = 65536;
constexpr int CW_CMAX_GU = 65536 + 8192;
static_assert((CW_CMAX_GU + DEPTH * NEXP * 2048) * 4 <= (int)CTL_ZERO_BYTES, "CTL words inside the memset region");
constexpr int CW_CMAX_DN = 262144;
static_assert((size_t)(CW_CMAX_DN + DEPTH * NEXP * 1024) * 4 <= 2 * MiB, "W_down column maxima fit below the weight copies");
constexpr size_t WS_HS = WS_HB + 64 * MiB;

constexpr int RING_BYTES = 131072;
constexpr int MISC_OFF = RING_BYTES;
constexpr int ULIST_OFF = RING_BYTES + 256;
constexpr int TOK_OFF = RING_BYTES + 256 + 2048;
constexpr int LDS_BYTES = 147456;
static_assert(TOK_OFF + 3 * 4096 + 256 + 1024 <= LDS_BYTES, "LDS map");

typedef unsigned short bf16;
typedef unsigned v4u __attribute__((ext_vector_type(4)));
typedef unsigned v2u __attribute__((ext_vector_type(2)));
typedef float f32x4 __attribute__((ext_vector_type(4)));
typedef GAS unsigned gu32;
#define RLX_AGENT __ATOMIC_RELAXED, __HIP_MEMORY_SCOPE_AGENT
#define LDS_WAIT() asm volatile("s_waitcnt lgkmcnt(0)" ::: "memory")
typedef float f32x2_t __attribute__((ext_vector_type(2)));
typedef __bf16 bf16x2_t __attribute__((ext_vector_type(2)));
__device__ __forceinline__ unsigned pk2(float lo, float hi) { const f32x2_t v = {lo, hi}; const bf16x2_t b = __builtin_convertvector(v, bf16x2_t); return __builtin_bit_cast(unsigned, b); }
__device__ __forceinline__ unsigned f2bf(float f) { return pk2(f, f) & 0xffffu; }
using pg8::pack_i8x4;
__device__ __forceinline__ float bf2f(unsigned short b) { return __builtin_bit_cast(float, ((unsigned)b) << 16); }
__device__ __forceinline__ float bflo(unsigned w) { return __builtin_bit_cast(float, w << 16); }
__device__ __forceinline__ float bfhi(unsigned w) { return __builtin_bit_cast(float, w & 0xffff0000u); }

#define XB_TMO      128
#define XB_XCNT(j)  (256  + 64 * (j))
#define XB_XSUB(j)  (1280 + 64 * (j))
#define XB_XGEN(j)  (2304 + 64 * (j))
#define XB_TOP      3328
#define XB_TOPGEN   3392
#define XCD_BAR_WORDS 3456
#define XB_SPIN_CAP (1u << 18)
__device__ __forceinline__ unsigned xb_ld(unsigned* p)              { return __hip_atomic_load(p, __ATOMIC_RELAXED, __HIP_MEMORY_SCOPE_AGENT); }
__device__ __forceinline__ unsigned xb_add(unsigned* p, unsigned v) { return __hip_atomic_fetch_add(p, v, __ATOMIC_RELAXED, __HIP_MEMORY_SCOPE_AGENT); }
__device__ __forceinline__ unsigned xb_xcc_id() { return (unsigned)__builtin_amdgcn_s_getreg((3 << 11) | 20) & 0xFu; }
#define XB_SPIN(cond, bar) do { unsigned _sp = 0; while (cond) { __builtin_amdgcn_s_sleep(1); \
    if ((++_sp & 255u) == 0u) { if (xb_ld(&(bar)[XB_TMO])) break; if (_sp > XB_SPIN_CAP) { atomicAdd(&(bar)[XB_TMO], 1u); break; } } } } while (0)
struct XcdBarrier { unsigned* bar; unsigned x; volatile LAS unsigned* st; };
__device__ __forceinline__ XcdBarrier xcd_barrier_post(unsigned* bar, volatile LAS unsigned* st) {
    XcdBarrier b; b.bar = bar; b.x = xb_xcc_id(); b.st = st;
    if (threadIdx.x == 0) (void)xb_add(&bar[XB_XCNT(b.x)], 1u);
    return b;
}
__device__ __forceinline__ void xcd_barrier_complete(unsigned* bar, unsigned x, unsigned& nloc, unsigned& nx) {
    const unsigned G = gridDim.x * gridDim.y * gridDim.z;
    unsigned sum, cnt, mine, sp = 0u;
    for (;;) {
        sum = 0u; cnt = 0u; mine = 0u;
#pragma unroll
        for (unsigned j = 0; j < 16; ++j) { const unsigned c = xb_ld(&bar[XB_XCNT(j)]); sum += c; cnt += (c > 0u) ? 1u : 0u; mine = (j == x) ? c : mine; }
        if (sum == G) break;
        __builtin_amdgcn_s_sleep(1);
        if ((++sp & 255u) == 0u) { if (xb_ld(&bar[XB_TMO])) break; if (sp > XB_SPIN_CAP) { atomicAdd(&bar[XB_TMO], 1u); break; } }
    }
    nloc = mine > 0u ? mine : 1u; nx = cnt > 0u ? cnt : 1u;
}
__device__ __forceinline__ void xcd_barrier(const XcdBarrier& b, bool leader) {
    asm volatile("s_waitcnt vmcnt(0)" ::: "memory");
    __syncthreads();
    if (leader) {
        unsigned* bar = b.bar;
        __builtin_amdgcn_s_waitcnt(0);
        unsigned nloc = b.st[0], nx = b.st[1];
        if (nloc == 0u) { xcd_barrier_complete(bar, b.x, nloc, nx); b.st[0] = nloc; b.st[1] = nx; }
        const unsigned old = xb_add(&bar[XB_XSUB(b.x)], 1u);
        const unsigned gen = old / nloc;
        if (old + 1u == (gen + 1u) * nloc) {
            __builtin_amdgcn_fence(__ATOMIC_RELEASE, "agent");
            asm volatile("s_waitcnt vmcnt(0)" ::: "memory");
            const unsigned og = xb_add(&bar[XB_TOP], 1u);
            const unsigned tg = og / nx;
            if (og + 1u == (tg + 1u) * nx) xb_add(&bar[XB_TOPGEN], 1u);
            else XB_SPIN(xb_ld(&bar[XB_TOPGEN]) == tg, bar);
            __builtin_amdgcn_fence(__ATOMIC_ACQUIRE, "agent");
            xb_add(&bar[XB_XGEN(b.x)], 1u);
            asm volatile("s_waitcnt vmcnt(0)" ::: "memory");
        } else {
            XB_SPIN(xb_ld(&bar[XB_XGEN(b.x)]) == gen, bar);
            __builtin_amdgcn_fence(__ATOMIC_ACQUIRE, "agent");
            asm volatile("s_waitcnt vmcnt(0)" ::: "memory");
        }
    }
    __syncthreads();
}

struct Frame {
    LAS unsigned char* lds;
    volatile LAS unsigned* MISC;
    gu32* ctl;
    int tid, lane, wave, vcu, G;
    const __attribute__((address_space(4))) unsigned char* ka;
    float* H;
    unsigned char* ws;
};
__device__ __forceinline__ const GAS float* inp(const Frame& F, int i) { return (const GAS float*)*(const float* const __attribute__((address_space(4)))*)(F.ka + 8 * i); }
__device__ __forceinline__ bf16* w_in_t(Frame& F, int l)  { return (bf16*)(F.ws + WS_W + (size_t)l * W_LAYER_B); }
__device__ __forceinline__ bf16* w_out_t(Frame& F, int l) { return (bf16*)(F.ws + WS_W + (size_t)l * W_LAYER_B + W_IN_B); }
__device__ __forceinline__ bf16* w_gu_t(Frame& F, int l)  { return (bf16*)(F.ws + WS_W + (size_t)l * W_LAYER_B + W_IN_B + W_OUT_B); }
__device__ __forceinline__ bf16* w_dn_t(Frame& F, int l)  { return (bf16*)(F.ws + WS_W + (size_t)l * W_LAYER_B + W_IN_B + W_OUT_B + W_GU_B); }

__device__ __forceinline__ void lds_barrier() { asm volatile("s_waitcnt lgkmcnt(0)" ::: "memory"); __builtin_amdgcn_s_barrier(); asm volatile("" ::: "memory"); }
template <int CTRL, int RM> __device__ __forceinline__ float dpp_mv(float v) { return __builtin_bit_cast(float, __builtin_amdgcn_update_dpp(__builtin_bit_cast(int, v), __builtin_bit_cast(int, v), CTRL, RM, 0xf, false)); }
__device__ __forceinline__ float wave_sum(float v) {
    v += dpp_mv<0xb1, 0xf>(v); v += dpp_mv<0x4e, 0xf>(v); v += dpp_mv<0x124, 0xf>(v); v += dpp_mv<0x128, 0xf>(v); v += dpp_mv<0x142, 0xa>(v); v += dpp_mv<0x143, 0xc>(v);
    return __builtin_bit_cast(float, __builtin_amdgcn_readlane(__builtin_bit_cast(int, v), 63));
}
__device__ __forceinline__ float wave_max(float v) {
    v = fmaxf(v, dpp_mv<0xb1, 0xf>(v)); v = fmaxf(v, dpp_mv<0x4e, 0xf>(v)); v = fmaxf(v, dpp_mv<0x124, 0xf>(v)); v = fmaxf(v, dpp_mv<0x128, 0xf>(v)); v = fmaxf(v, dpp_mv<0x142, 0xa>(v)); v = fmaxf(v, dpp_mv<0x143, 0xc>(v));
    return __builtin_bit_cast(float, __builtin_amdgcn_readlane(__builtin_bit_cast(int, v), 63));
}
__device__ __forceinline__ float xmax16(float v) { const unsigned u = __builtin_bit_cast(unsigned, v); auto r = __builtin_amdgcn_permlane16_swap(u, u, false, false); return fmaxf(__builtin_bit_cast(float, (unsigned)r[0]), __builtin_bit_cast(float, (unsigned)r[1])); }

template <int MODE>
__device__ __forceinline__ void p0_transpose_item(const GAS float* W, int K, int N, bf16* WT, LAS float* scr, int item, int lane) {
    const int nblk = (N + 31) / 32, kb = item / nblk, nb = item % nblk, k0 = 64 * kb, n0 = 32 * nb;
    const bool nok = (n0 + (lane & 31)) < N;
#pragma unroll 8
    for (int i = 0; i < 32; ++i) { const int kk = 2 * i + (lane >> 5); scr[kk * 33 + (lane & 31)] = nok ? W[(size_t)(k0 + kk) * N + n0 + (lane & 31)] : 0.f; }
    LDS_WAIT(); asm volatile("" ::: "memory");
    const int c = lane & 7;
#pragma unroll
    for (int j = 0; j < 4; ++j) { const int n = (lane >> 3) + 8 * j; const LAS float* s = scr + (8 * c) * 33 + n;
        v4u o; o.x = pk2(s[0 * 33], s[1 * 33]); o.y = pk2(s[2 * 33], s[3 * 33]); o.z = pk2(s[4 * 33], s[5 * 33]); o.w = pk2(s[6 * 33], s[7 * 33]);
        const int ns = n0 + n;
        int nd = ns;
        if (MODE == 1) { const int half = ns >> 10, cc = ns & 1023; nd = (cc >> 7) * 256 + half * 128 + (cc & 127); }
        if (ns < N) *(GAS v4u*)(WT + (size_t)nd * K + k0 + 8 * c) = o; }
    LDS_WAIT(); asm volatile("" ::: "memory");
}
__device__ __forceinline__ void ln_row(f32x4 (&v)[4], const GAS float* g, const GAS float* b, int lane) {
    float s = 0.f;
#pragma unroll
    for (int j = 0; j < 4; ++j) s += (v[j].x + v[j].y) + (v[j].z + v[j].w);
    const float mean = wave_sum(s) * (1.f / D); float s2 = 0.f;
#pragma unroll
    for (int j = 0; j < 4; ++j) { v[j] = v[j] - mean; s2 += (v[j].x * v[j].x + v[j].y * v[j].y) + (v[j].z * v[j].z + v[j].w * v[j].w); }
    const float rstd = 1.f / sqrtf(wave_sum(s2) * (1.f / D) + LN_EPS);
#pragma unroll
    for (int j = 0; j < 4; ++j) { const f32x4 gg = *(const GAS f32x4*)(g + 4 * lane + 256 * j), bb = *(const GAS f32x4*)(b + 4 * lane + 256 * j); v[j] = v[j] * rstd * gg + bb; }
}
__device__ __forceinline__ float store_row_q(const f32x4 (&v)[4], GAS signed char* qrow, GAS float* hsm, int lane) {
    float mx = 0.f;
#pragma unroll
    for (int j = 0; j < 4; ++j) mx = fmaxf(fmaxf(mx, fmaxf(fabsf(v[j].x), fabsf(v[j].y))), fmaxf(fabsf(v[j].z), fabsf(v[j].w)));
    mx = wave_max(mx); const float inv = mx > 0.f ? 127.0f / mx : 0.f;
#pragma unroll
    for (int j = 0; j < 4; ++j) *(GAS unsigned*)(qrow + 4 * lane + 256 * j) = pack_i8x4(v[j].x * inv, v[j].y * inv, v[j].z * inv, v[j].w * inv);
    if (lane == 0) *hsm = mx * (1.0f / 127.0f);
    return mx * (1.0f / 127.0f);
}
__device__ __forceinline__ void wave_sum2(float& x, float& y) {
    x += dpp_mv<0xb1, 0xf>(x); y += dpp_mv<0xb1, 0xf>(y); x += dpp_mv<0x4e, 0xf>(x); y += dpp_mv<0x4e, 0xf>(y); x += dpp_mv<0x124, 0xf>(x); y += dpp_mv<0x124, 0xf>(y);
    x += dpp_mv<0x128, 0xf>(x); y += dpp_mv<0x128, 0xf>(y); x += dpp_mv<0x142, 0xa>(x); y += dpp_mv<0x142, 0xa>(y); x += dpp_mv<0x143, 0xc>(x); y += dpp_mv<0x143, 0xc>(y);
    x = __builtin_bit_cast(float, __builtin_amdgcn_readlane(__builtin_bit_cast(int, x), 63)); y = __builtin_bit_cast(float, __builtin_amdgcn_readlane(__builtin_bit_cast(int, y), 63));
}
__device__ __forceinline__ void wave_max2(float& x, float& y) {
    x = fmaxf(x, dpp_mv<0xb1, 0xf>(x)); y = fmaxf(y, dpp_mv<0xb1, 0xf>(y)); x = fmaxf(x, dpp_mv<0x4e, 0xf>(x)); y = fmaxf(y, dpp_mv<0x4e, 0xf>(y)); x = fmaxf(x, dpp_mv<0x124, 0xf>(x)); y = fmaxf(y, dpp_mv<0x124, 0xf>(y));
    x = fmaxf(x, dpp_mv<0x128, 0xf>(x)); y = fmaxf(y, dpp_mv<0x128, 0xf>(y)); x = fmaxf(x, dpp_mv<0x142, 0xa>(x)); y = fmaxf(y, dpp_mv<0x142, 0xa>(y)); x = fmaxf(x, dpp_mv<0x143, 0xc>(x)); y = fmaxf(y, dpp_mv<0x143, 0xc>(y));
    x = __builtin_bit_cast(float, __builtin_amdgcn_readlane(__builtin_bit_cast(int, x), 63)); y = __builtin_bit_cast(float, __builtin_amdgcn_readlane(__builtin_bit_cast(int, y), 63));
}
__device__ __forceinline__ void ln_row2(f32x4 (&a)[4], f32x4 (&c)[4], const GAS float* g, const GAS float* b, int lane) {
    float sa = 0.f, sc = 0.f;
#pragma unroll
    for (int j = 0; j < 4; ++j) { sa += (a[j].x + a[j].y) + (a[j].z + a[j].w); sc += (c[j].x + c[j].y) + (c[j].z + c[j].w); }
    wave_sum2(sa, sc); const float ma = sa * (1.f / D), mc = sc * (1.f / D); float qa = 0.f, qc = 0.f;
#pragma unroll
    for (int j = 0; j < 4; ++j) { a[j] = a[j] - ma; c[j] = c[j] - mc; qa += (a[j].x * a[j].x + a[j].y * a[j].y) + (a[j].z * a[j].z + a[j].w * a[j].w); qc += (c[j].x * c[j].x + c[j].y * c[j].y) + (c[j].z * c[j].z + c[j].w * c[j].w); }
    wave_sum2(qa, qc); const float ra = 1.f / sqrtf(qa * (1.f / D) + LN_EPS), rc = 1.f / sqrtf(qc * (1.f / D) + LN_EPS);
#pragma unroll
    for (int j = 0; j < 4; ++j) { const f32x4 gg = *(const GAS f32x4*)(g + 4 * lane + 256 * j), bb = *(const GAS f32x4*)(b + 4 * lane + 256 * j); a[j] = a[j] * ra * gg + bb; c[j] = c[j] * rc * gg + bb; }
}
__device__ __forceinline__ void store_row_q2(const f32x4 (&a)[4], const f32x4 (&c)[4], GAS signed char* qa, GAS signed char* qc, GAS float* hsa, GAS float* hsc, int lane, float& sca, float& scc) {
    float xa = 0.f, xc = 0.f;
#pragma unroll
    for (int j = 0; j < 4; ++j) { xa = fmaxf(fmaxf(xa, fmaxf(fabsf(a[j].x), fabsf(a[j].y))), fmaxf(fabsf(a[j].z), fabsf(a[j].w))); xc = fmaxf(fmaxf(xc, fmaxf(fabsf(c[j].x), fabsf(c[j].y))), fmaxf(fabsf(c[j].z), fabsf(c[j].w))); }
    wave_max2(xa, xc); const float ia = xa > 0.f ? 127.0f / xa : 0.f, ic = xc > 0.f ? 127.0f / xc : 0.f;
#pragma unroll
    for (int j = 0; j < 4; ++j) { *(GAS unsigned*)(qa + 4 * lane + 256 * j) = pack_i8x4(a[j].x * ia, a[j].y * ia, a[j].z * ia, a[j].w * ia); *(GAS unsigned*)(qc + 4 * lane + 256 * j) = pack_i8x4(c[j].x * ic, c[j].y * ic, c[j].z * ic, c[j].w * ic); }
    sca = xa * (1.0f / 127.0f); scc = xc * (1.0f / 127.0f);
    if (lane == 0) { *hsa = sca; *hsc = scc; }
}
__device__ __forceinline__ void load_t(f32x4 (&v)[4], const GAS bf16* hr, const GAS bf16* mr, int lane) {
#pragma unroll
    for (int j = 0; j < 4; ++j) { const v2u h = *(const GAS v2u*)(hr + 4 * lane + 256 * j); const v2u w = *(const GAS v2u*)(mr + 4 * lane + 256 * j);
        v[j].x = bflo(h.x) * ALPHA + bflo(w.x); v[j].y = bfhi(h.x) * ALPHA + bfhi(w.x); v[j].z = bflo(h.y) * ALPHA + bflo(w.y); v[j].w = bfhi(h.y) * ALPHA + bfhi(w.y); }
}
__device__ __forceinline__ void load_raw(v2u (&hr)[4], v2u (&mr)[4], const GAS bf16* hp, const GAS bf16* mp, int lane) {
#pragma unroll
    for (int j = 0; j < 4; ++j) { hr[j] = *(const GAS v2u*)(hp + 4 * lane + 256 * j); mr[j] = *(const GAS v2u*)(mp + 4 * lane + 256 * j); }
}
__device__ __forceinline__ void load_raw_q(v2u (&hr)[4], v2u (&mr)[4], const GAS signed char* hqp, const GAS float* hsp, const GAS bf16* mp, int lane) {
#pragma unroll
    for (int j = 0; j < 4; ++j) { hr[j].x = *(const GAS unsigned*)(hqp + 4 * lane + 256 * j); hr[j].y = 0u; mr[j] = *(const GAS v2u*)(mp + 4 * lane + 256 * j); }
    hr[0].y = __float_as_uint(*hsp);
}
__device__ __forceinline__ void cvt_t_q(f32x4 (&v)[4], const v2u (&hr)[4], const v2u (&mr)[4]) {
    const float sa = __uint_as_float(hr[0].y) * ALPHA;
#pragma unroll
    for (int j = 0; j < 4; ++j) { const int w = (int)hr[j].x;
        v[j].x = (float)((w << 24) >> 24) * sa + bflo(mr[j].x); v[j].y = (float)((w << 16) >> 24) * sa + bfhi(mr[j].x); v[j].z = (float)((w << 8) >> 24) * sa + bflo(mr[j].y); v[j].w = (float)(w >> 24) * sa + bfhi(mr[j].y); }
}
__device__ __forceinline__ void cvt_t(f32x4 (&v)[4], const v2u (&hr)[4], const v2u (&mr)[4]) {
#pragma unroll
    for (int j = 0; j < 4; ++j) { v[j].x = bflo(hr[j].x) * ALPHA + bflo(mr[j].x); v[j].y = bfhi(hr[j].x) * ALPHA + bfhi(mr[j].x); v[j].z = bflo(hr[j].y) * ALPHA + bflo(mr[j].y); v[j].w = bfhi(hr[j].y) * ALPHA + bfhi(mr[j].y); }
}
__device__ __forceinline__ void store_row_b(const f32x4 (&v)[4], GAS bf16* orow, int lane) {
#pragma unroll
    for (int j = 0; j < 4; ++j) { v2u w; w.x = pk2(v[j].x, v[j].y); w.y = pk2(v[j].z, v[j].w); *(GAS v2u*)(orow + 4 * lane + 256 * j) = w; }
}
__device__ __forceinline__ void store_row_f(const f32x4 (&v)[4], float* orow, int lane) {
#pragma unroll
    for (int j = 0; j < 4; ++j) *(GAS f32x4*)(orow + 4 * lane + 256 * j) = v[j];
}
struct PanelSrc { const GAS float* W; const GAS float* W2; int N; signed char* WT; gu32* cmax; int p; int mode; int fp8; };
__device__ __forceinline__ PanelSrc p0_panel_src(Frame& F, int it) {
    constexpr int P_IN = (NPROJ + 31) / 32 + 8, P_GU = 2048 / 32, P_DN = D / 32, PAN_LAYER = P_IN + NEXP * P_GU + NEXP * P_DN;
    const int l = it / PAN_LAYER; int r = it % PAN_LAYER; PanelSrc s; s.W2 = inp(F, 4) + (size_t)l * GLR_RANK * 256;
    if (r < P_IN) { s.W = inp(F, 3) + (size_t)l * D * NPROJ; s.N = NPROJ; s.WT = (signed char*)w_in_t(F, l); s.cmax = F.ctl + CW_CMAX_IN + l * NPROJ_PAD; s.fp8 = 0;
        if (r < P_IN - 8) { s.p = r; s.mode = 2; } else { s.p = r - (P_IN - 8); s.mode = 3; } }
    else if (r < P_IN + NEXP * P_GU) { r -= P_IN; const int e = r / P_GU; s.W = inp(F, 15) + ((size_t)l * NEXP + e) * D * 2048; s.N = 2048; s.WT = (signed char*)w_gu_t(F, l) + (size_t)e * 2048 * D; s.cmax = F.ctl + CW_CMAX_GU + (l * NEXP + e) * 2048; s.p = r % P_GU; s.mode = 1; s.fp8 = 0; }
    else { r -= P_IN + NEXP * P_GU; const int e = r / P_DN; s.W = inp(F, 17) + ((size_t)l * NEXP + e) * DFF * D; s.N = D; s.WT = (signed char*)w_dn_t(F, l) + (size_t)e * D * DFF; s.cmax = F.ctl + CW_CMAX_DN + (l * NEXP + e) * D; s.p = r % P_DN; s.mode = 0; s.fp8 = 1; }
    return s;
}
__device__ __forceinline__ void p0_panel_load(Frame& F, const PanelSrc& s, float (&rg)[64]) {
    const int lane = F.lane, wave = F.wave, n0 = 32 * s.p; const bool nok = (n0 + (lane & 31)) < s.N;
    if (s.mode == 3) {
        float wg[GLR_RANK];
#pragma unroll
        for (int r = 0; r < GLR_RANK; ++r) wg[r] = s.W2[r * 256 + n0 + (lane & 31)];
#pragma unroll
        for (int i = 0; i < 64; ++i) { const int k = 2 * (8 * i + wave) + (lane >> 5); const GAS f32x4* zr = (const GAS f32x4*)(s.W + (size_t)k * s.N + SRC_GLR); float a = 0.f;
#pragma unroll
            for (int q = 0; q < 4; ++q) { const f32x4 z = zr[q]; a += z.x * wg[4 * q] + z.y * wg[4 * q + 1] + z.z * wg[4 * q + 2] + z.w * wg[4 * q + 3]; }
            rg[i] = a; }
        return; }
#pragma unroll
    for (int i = 0; i < 64; ++i) { const int k = 2 * (8 * i + wave) + (lane >> 5); rg[i] = nok ? s.W[(size_t)k * s.N + n0 + (lane & 31)] : 0.f; }
}
__device__ __forceinline__ void p0_panels(Frame& F) {
    constexpr int P_IN = (NPROJ + 31) / 32 + 8, P_GU = 2048 / 32, P_DN = D / 32, PAN_LAYER = P_IN + NEXP * P_GU + NEXP * P_DN, NPAN = DEPTH * PAN_LAYER;
    LAS float* pan = (LAS float*)F.lds; LAS float* pmx = (LAS float*)(F.lds + TOK_OFF);
    const int tid = F.tid, lane = F.lane, wave = F.wave;
    int it = F.vcu; if (it >= NPAN) return;
    float rg[64]; PanelSrc cur = p0_panel_src(F, it); p0_panel_load(F, cur, rg);
    for (;;) {
#pragma unroll
        for (int i = 0; i < 64; ++i) { const int k = 2 * (8 * i + wave) + (lane >> 5); pan[k * 32 + (lane & 31)] = rg[i]; }
        lds_barrier();
        const int itn = it + F.G; const bool more = itn < NPAN; PanelSrc nxt = cur; if (more) { nxt = p0_panel_src(F, itn); p0_panel_load(F, nxt, rg); }
        const int n = tid & 31, ks = tid >> 5;
        float mx = 0.f;
#pragma unroll 8
        for (int i = 0; i < 64; ++i) mx = fmaxf(mx, fabsf(pan[(64 * ks + i) * 32 + n]));
        pmx[ks * 32 + n] = mx;
        lds_barrier();
        float cm = 0.f;
#pragma unroll
        for (int q = 0; q < 16; ++q) cm = fmaxf(cm, pmx[q * 32 + n]);
        const float inv = cm > 0.f ? (cur.fp8 ? pg8::WDN_SC : 127.0f) / cm : 0.f;
        const int ns = 32 * cur.p + n; int nd = ns; bool okc = ns < cur.N;
        if (cur.mode == 1) { const int half = ns >> 10, cc = ns & 1023; nd = (cc >> 7) * 256 + half * 128 + (cc & 127); }
        else if (cur.mode == 2) { nd = ns < SRC_GLR ? ns : ns + (C_GOG - SRC_GLR - GLR_RANK); okc = okc && !(ns >= SRC_GLR && ns < SRC_GLR + GLR_RANK); }
        else if (cur.mode == 3) { nd = C_GLG + ns; okc = ns < 256; }
        if (okc) {
            if (ks == 0) cur.cmax[nd] = __float_as_uint(cm);
            GAS v4u* dst = (GAS v4u*)(cur.WT + (size_t)nd * 1024 + 64 * ks);
#pragma unroll 1
            for (int g4 = 0; g4 < 4; ++g4) { unsigned w[4];
#pragma unroll
            for (int gg = 0; gg < 4; ++gg) { const int g = 4 * g4 + gg; const int kb = (64 * ks + 4 * g) * 32 + n;
                const float x0 = pan[kb] * inv, x1 = pan[kb + 32] * inv, x2 = pan[kb + 64] * inv, x3 = pan[kb + 96] * inv;
                if (cur.fp8) { int v = __builtin_amdgcn_cvt_pk_fp8_f32(x0, x1, 0, false); v = __builtin_amdgcn_cvt_pk_fp8_f32(x2, x3, v, true); w[gg] = (unsigned)v; }
                else w[gg] = pack_i8x4(x0, x1, x2, x3); }
            dst[g4] = (v4u){w[0], w[1], w[2], w[3]}; } }
        lds_barrier();
        if (!more) break;
        it = itn; cur = nxt;
    }
    __syncthreads();
}
__device__ __forceinline__ void p0_prologue(Frame& F) {
    p0_panels(F);
    LAS float* scr = (LAS float*)(F.lds + F.wave * 16384);
    const int gw = F.vcu * NWAVES + F.wave, NGW = F.G * NWAVES;
    constexpr int I_OUT = (D / 64) * (D / 32);
    for (int it = gw; it < DEPTH * I_OUT; it += NGW) { const int l = it / I_OUT, r = it % I_OUT; p0_transpose_item<0>(inp(F, 10) + (size_t)l * D * D, D, D, w_out_t(F, l), scr, r, F.lane); }
    GAS signed char* HQ = (GAS signed char*)(F.ws + WS_HB); GAS float* HS = (GAS float*)(F.ws + WS_HS);
    for (int m = gw; m < M; m += NGW) { f32x4 v[4]; const GAS float* xr = inp(F, 0) + (size_t)m * D;
#pragma unroll
        for (int j = 0; j < 4; ++j) v[j] = *(const GAS f32x4*)(xr + 4 * F.lane + 256 * j);
        ln_row(v, inp(F, 1), inp(F, 2), F.lane); store_row_q(v, HQ + (size_t)m * D, HS + m, F.lane); }
}

__device__ __forceinline__ float sigmoidf_(float x) { return __builtin_amdgcn_rcpf(1.0f + __expf(-x)); }
__device__ __forceinline__ float siluf_(float x) { return x * sigmoidf_(x); }
typedef short s16x4 __attribute__((ext_vector_type(4)));
typedef short v4i16_t __attribute__((ext_vector_type(4)));
typedef short bf16x8_t __attribute__((ext_vector_type(8)));
__device__ __forceinline__ s16x4 tr4(const LAS unsigned char* p) { return __builtin_bit_cast(s16x4, __builtin_amdgcn_ds_read_tr16_b64_v4i16((LAS v4i16_t*)p)); }
__device__ __forceinline__ bf16x8_t cat8(s16x4 a, s16x4 b) { return __builtin_shufflevector(a, b, 0, 1, 2, 3, 4, 5, 6, 7); }
constexpr int RAWP = 136;
constexpr int SC_QRAW = 0, SC_KRAW = 8704, SC_ZRAW = TOK_OFF  , SC_VRAW = 24576, SC_QI = 43008, SC_KI = 53248, SC_QS = 63488, SC_KS = 73728, SC_ST = 83968, SC_SEG = 120832, SC_EGL = 122880, SC_GN = 123136, SC_W = 123648, SC_BG = 127744, SC_XS = 128000, SC_XF = 128512;
constexpr int IMGP = 160, STP = 144;
template <int DV, bool GLA>
__device__ __forceinline__ void scan_chunked(Frame& F, int l, int b, int hd) {
    constexpr int NVT = DV / 16, VP = DV * 2 + 32, NOWN = NVT / 4, NVL = DV / 64;
    LAS unsigned char* L = F.lds;
    const bf16* proj = (const bf16*)(F.ws + WS_PROJ); bf16* Y = (bf16*)(F.ws + WS_Y);
    const int qc = GLA ? C_GQ + hd * 64 : C_HQ + hd * 64, kc = GLA ? C_GK + hd * 64 : C_HF + hd * 64, vc = GLA ? C_GV + hd * 128 : C_HI + hd * 64,
              ogc = GLA ? C_GOG + hd * 128 : C_HOG + hd * 64, yc = GLA ? hd * 128 : 512 + hd * 64;
    const int tid = F.tid, lane = F.lane, wave = F.wave;
    const int d = 8 * wave + (lane & 7), seg = lane >> 3;
    const int li = lane & 15, q4 = lane >> 4, lrow = (lane & 15) >> 2, lcol = 4 * (lane & 3);
    const size_t rowbase = (size_t)b * SEQ;
    float lb = 0.f;
    __syncthreads();
    if (GLA) {
        if (tid < 64) *(LAS float*)(L + SC_BG + tid * 4) = inp(F, 5)[l * 256 + hd * 64 + tid];
    } else if (l > 0) { const float r0 = inp(F, 7)[hd * 64 + d], r1 = inp(F, 7)[256 + hd * 64 + d]; lb = 1.0f / (1.0f + __expf(r0 - r1)); }
    const GAS float* gn = GLA ? inp(F, 6) + l * 128 : inp(F, 8) + l * 64;
    __syncthreads();
    if (tid < DV) *(LAS float*)(L + SC_GN + tid * 4) = gn[tid];
    for (int i = tid; i < DV * STP / 16; i += 512) *(LAS v4u*)(L + SC_ST + i * 16) = (v4u){0u, 0u, 0u, 0u};
    v4u rq, rk, rz, rv[NVL];
    auto issue = [&](int c) {
        const size_t r0 = rowbase + (size_t)c * 64;
        { const int row = tid >> 3, ch = tid & 7; const bf16* p = proj + (r0 + row) * NPROJ_PAD; rq = *(const GAS v4u*)(p + qc + 8 * ch); rk = *(const GAS v4u*)(p + kc + 8 * ch); }
        if (GLA) { const int row = tid >> 3, ch = tid & 7; rz = *(const GAS v4u*)(proj + (r0 + row) * NPROJ_PAD + C_GLG + hd * 64 + 8 * ch); }
#pragma unroll
        for (int j = 0; j < NVL; ++j) { const int idx = tid + 512 * j, row = idx / (DV / 8), ch = idx % (DV / 8); rv[j] = *(const GAS v4u*)(proj + (r0 + row) * NPROJ_PAD + vc + 8 * ch); }
    };
    auto commit_qkz = [&]() {
        { const int row = tid >> 3, ch = tid & 7; const int o = row * RAWP + ch * 16;
            *(LAS v2u*)(L + SC_QRAW + o) = (v2u){rq.x, rq.y}; *(LAS v2u*)(L + SC_QRAW + o + 8) = (v2u){rq.z, rq.w};
            *(LAS v2u*)(L + SC_KRAW + o) = (v2u){rk.x, rk.y}; *(LAS v2u*)(L + SC_KRAW + o + 8) = (v2u){rk.z, rk.w};
            if (GLA) { *(LAS v2u*)(L + SC_ZRAW + o) = (v2u){rz.x, rz.y}; *(LAS v2u*)(L + SC_ZRAW + o + 8) = (v2u){rz.z, rz.w}; } }
    };
    auto commit_v = [&]() {
#pragma unroll
        for (int j = 0; j < NVL; ++j) { const int idx = tid + 512 * j, row = idx / (DV / 8), ch = idx % (DV / 8); *(LAS v4u*)(L + SC_VRAW + row * VP + ch * 16) = rv[j]; }
    };
    issue(0); commit_qkz(); commit_v();
    f32x4 S[4];
#pragma unroll
    for (int dt = 0; dt < 4; ++dt) S[dt] = (f32x4){0.f, 0.f, 0.f, 0.f};
    if (tid < 8) *(LAS int*)(L + SC_XF + tid * 4) = 0;
    __syncthreads();
#pragma unroll 1
    for (int c = 0; c < SEQ / 64; ++c) {
        const int t0 = c * 64;
        if (c + 1 < SEQ / 64) issue(c + 1);
        float cs[8], kv[8];
        {
            float run = 0.f; float bg = 0.f;
            if (GLA) bg = *(const LAS float*)(L + SC_BG + d * 4);
#pragma unroll
            for (int e = 0; e < 8; ++e) { const int T = 8 * seg + e; float g;
                if (GLA) { const float lg = bf2f(*(const LAS unsigned short*)(L + SC_ZRAW + T * RAWP + d * 2)) + bg;
                    g = (fminf(lg, 0.f) - __logf(1.0f + __expf(-fabsf(lg)))) * (1.0f / 16.0f);
                    kv[e] = bf2f(*(const LAS unsigned short*)(L + SC_KRAW + T * RAWP + d * 2)); }
                else { const float z = bf2f(*(const LAS unsigned short*)(L + SC_KRAW + T * RAWP + d * 2)); const float f = lb + (1.0f - lb) * sigmoidf_(z); g = __logf(f); kv[e] = 1.0f - f; }
                run += g; cs[e] = run; }
            *(LAS float*)(L + SC_SEG + (seg * 64 + d) * 4) = run;
        }
        LDS_WAIT(); asm volatile("" ::: "memory");
        {
            float pre = 0.f, rd = 0.f, gl = 0.f;
#pragma unroll
            for (int s2 = 0; s2 < 8; ++s2) { const float v = *(const LAS float*)(L + SC_SEG + (s2 * 64 + d) * 4); if (s2 < seg) pre += v; if (s2 < 4) rd += v; gl += v; }
            const float er = __expf(rd), eglr = __expf(gl - rd);
            float qi[8], ki[8], qs[8], ks[8]; unsigned short qr[8];
#pragma unroll
            for (int e = 0; e < 8; ++e) qr[e] = *(const LAS unsigned short*)(L + SC_QRAW + (8 * seg + e) * RAWP + d * 2);
#pragma unroll
            for (int e = 0; e < 8; ++e) { const float gc = pre + cs[e]; const float E1 = __expf(gc - rd), E2 = __expf(rd - gc);
                float qv = bf2f(qr[e]); qv = GLA ? qv * 0.125f : siluf_(qv);
                qi[e] = qv * E1; qs[e] = qi[e] * er; ki[e] = kv[e] * E2; ks[e] = ki[e] * eglr; }
            v4u w;
            w.x = pk2(qi[0], qi[1]); w.y = pk2(qi[2], qi[3]); w.z = pk2(qi[4], qi[5]); w.w = pk2(qi[6], qi[7]); *(LAS v4u*)(L + SC_QI + d * IMGP + seg * 16) = w;
            w.x = pk2(ki[0], ki[1]); w.y = pk2(ki[2], ki[3]); w.z = pk2(ki[4], ki[5]); w.w = pk2(ki[6], ki[7]); *(LAS v4u*)(L + SC_KI + d * IMGP + seg * 16) = w;
            w.x = pk2(qs[0], qs[1]); w.y = pk2(qs[2], qs[3]); w.z = pk2(qs[4], qs[5]); w.w = pk2(qs[6], qs[7]); *(LAS v4u*)(L + SC_QS + d * IMGP + seg * 16) = w;
            w.x = pk2(ks[0], ks[1]); w.y = pk2(ks[2], ks[3]); w.z = pk2(ks[4], ks[5]); w.w = pk2(ks[6], ks[7]); *(LAS v4u*)(L + SC_KS + d * IMGP + seg * 16) = w;
            if (seg == 0) *(LAS float*)(L + SC_EGL + d * 4) = __expf(gl);
        }
        lds_barrier();
        const LAS unsigned char* STc = L + SC_ST + (c & 1) * (DV * STP);
        LAS unsigned char* STn = L + SC_ST + ((c + 1) & 1) * (DV * STP);
        {
            constexpr int NH = NVT / 2;
            const int it = wave & 3, hh = wave >> 2, I0 = 16 * it, V0 = hh * NH; const size_t row_i = rowbase + t0 + I0 + li;
            v2u ogr[NH];
#pragma unroll
            for (int vt = 0; vt < NH; ++vt) ogr[vt] = *(const GAS v2u*)(proj + row_i * NPROJ_PAD + ogc + 16 * (V0 + vt) + 4 * q4);
            f32x4 pt[4]; s16x4 sf[2][2];
#pragma unroll
            for (int jt = 0; jt < 4; ++jt) pt[jt] = (f32x4){0.f, 0.f, 0.f, 0.f};
#pragma unroll
            for (int ks = 0; ks < 2; ++ks) { const int R0 = 32 * ks + 8 * q4 + lrow; s16x4 kf[4][2], qf[2];
#pragma unroll
                for (int jt = 0; jt < 4; ++jt) { kf[jt][0] = tr4(L + SC_KI + R0 * IMGP + (16 * jt + lcol) * 2); kf[jt][1] = tr4(L + SC_KI + (R0 + 4) * IMGP + (16 * jt + lcol) * 2); }
                qf[0] = tr4(L + SC_QI + R0 * IMGP + (I0 + lcol) * 2); qf[1] = tr4(L + SC_QI + (R0 + 4) * IMGP + (I0 + lcol) * 2);
                sf[ks][0] = tr4(L + SC_QS + R0 * IMGP + (I0 + lcol) * 2); sf[ks][1] = tr4(L + SC_QS + (R0 + 4) * IMGP + (I0 + lcol) * 2);
#pragma unroll
                for (int jt = 0; jt < 4; ++jt) pt[jt] = __builtin_amdgcn_mfma_f32_16x16x32_bf16(cat8(kf[jt][0], kf[jt][1]), cat8(qf[0], qf[1]), pt[jt], 0, 0, 0); }
#pragma unroll
            for (int jt = 0; jt < 4; ++jt)
#pragma unroll
                for (int r = 0; r < 4; ++r) pt[jt][r] = (16 * jt + 4 * q4 + r <= I0 + li) ? pt[jt][r] : 0.f;
            bf16x8_t pb[2], qb[2];
#pragma unroll
            for (int s2 = 0; s2 < 2; ++s2) { v4u w; w.x = pk2(pt[2 * s2][0], pt[2 * s2][1]); w.y = pk2(pt[2 * s2][2], pt[2 * s2][3]); w.z = pk2(pt[2 * s2 + 1][0], pt[2 * s2 + 1][1]); w.w = pk2(pt[2 * s2 + 1][2], pt[2 * s2 + 1][3]);
                pb[s2] = __builtin_bit_cast(bf16x8_t, w); qb[s2] = cat8(sf[s2][0], sf[s2][1]); }
            f32x4 o[NH]; float ss = 0.f;
#pragma unroll
            for (int vp = 0; vp < NH; vp += 2) {
                s16x4 vf[2][2][2]; bf16x8_t stf[2][2];
#pragma unroll
                for (int x = 0; x < 2; ++x)
#pragma unroll
                    for (int s2 = 0; s2 < 2; ++s2) { const int R0 = 32 * s2 + 4 * q4 + lrow;
                        vf[x][s2][0] = tr4(L + SC_VRAW + R0 * VP + (16 * (V0 + vp + x) + lcol) * 2); vf[x][s2][1] = tr4(L + SC_VRAW + (R0 + 16) * VP + (16 * (V0 + vp + x) + lcol) * 2);
                        stf[x][s2] = *(const LAS bf16x8_t*)(STc + (16 * (V0 + vp + x) + li) * STP + (32 * s2 + 8 * q4) * 2); }
#pragma unroll
                for (int x = 0; x < 2; ++x) { f32x4 acc = (f32x4){0.f, 0.f, 0.f, 0.f};
#pragma unroll
                    for (int s2 = 0; s2 < 2; ++s2) acc = __builtin_amdgcn_mfma_f32_16x16x32_bf16(cat8(vf[x][s2][0], vf[x][s2][1]), pb[s2], acc, 0, 0, 0);
#pragma unroll
                    for (int s2 = 0; s2 < 2; ++s2) acc = __builtin_amdgcn_mfma_f32_16x16x32_bf16(stf[x][s2], qb[s2], acc, 0, 0, 0);
                    o[vp + x] = acc; ss += (acc[0] * acc[0] + acc[1] * acc[1]) + (acc[2] * acc[2] + acc[3] * acc[3]); } }
            ss += __shfl_xor(ss, 16); ss += __shfl_xor(ss, 32);
            if (q4 == 0) *(LAS float*)(L + SC_XS + (wave * 16 + li) * 4) = ss;
            LDS_WAIT(); asm volatile("" ::: "memory");
            if (lane == 0) *(volatile LAS int*)(L + SC_XF + wave * 4) = c + 1;
            if (wave < NVT) { const int vt = wave;
                bf16x8_t bk[4][2]; float eg[4];
#pragma unroll
                for (int dt = 0; dt < 4; ++dt) { eg[dt] = *(const LAS float*)(L + SC_EGL + (16 * dt + li) * 4);
#pragma unroll
                    for (int s2 = 0; s2 < 2; ++s2) bk[dt][s2] = *(const LAS bf16x8_t*)(L + SC_KS + (16 * dt + li) * IMGP + (32 * s2 + 8 * q4) * 2); }
                s16x4 vg[2][2];
#pragma unroll
                for (int s2 = 0; s2 < 2; ++s2) { const int R0 = 32 * s2 + 8 * q4 + lrow;
                    vg[s2][0] = tr4(L + SC_VRAW + R0 * VP + (16 * vt + lcol) * 2); vg[s2][1] = tr4(L + SC_VRAW + (R0 + 4) * VP + (16 * vt + lcol) * 2); }
#pragma unroll
                for (int dt = 0; dt < 4; ++dt) { f32x4 acc = S[dt] * eg[dt];
#pragma unroll
                    for (int s2 = 0; s2 < 2; ++s2) acc = __builtin_amdgcn_mfma_f32_16x16x32_bf16(cat8(vg[s2][0], vg[s2][1]), bk[dt][s2], acc, 0, 0, 0);
                    S[dt] = acc; }
#pragma unroll
                for (int dt = 0; dt < 4; ++dt)
#pragma unroll
                    for (int r = 0; r < 4; r += 2) { const unsigned w = pk2(S[dt][r], S[dt][r + 1]);
                        *(LAS unsigned short*)(STn + (16 * vt + 4 * q4 + r) * STP + (16 * dt + li) * 2) = (unsigned short)(w & 0xffffu);
                        *(LAS unsigned short*)(STn + (16 * vt + 4 * q4 + r + 1) * STP + (16 * dt + li) * 2) = (unsigned short)(w >> 16); } }
            { const int pw = wave ^ 4; int sp = 0;
                while (*(volatile LAS int*)(L + SC_XF + pw * 4) != c + 1) { __builtin_amdgcn_s_sleep(1); if (++sp > (1 << 20)) break; }
                asm volatile("" ::: "memory");
                ss += *(volatile LAS float*)(L + SC_XS + (pw * 16 + li) * 4); }
            const float rn = __builtin_amdgcn_rsqf(ss * (1.0f / DV) + RMS_EPS);
#pragma unroll
            for (int vp = 0; vp < NH; vp += 2) { v2u w2[2];
#pragma unroll
                for (int x = 0; x < 2; ++x) { const int vt = vp + x; const f32x4 g4 = *(const LAS f32x4*)(L + SC_GN + (16 * (V0 + vt) + 4 * q4) * 4);
                    const float y0 = o[vt][0] * rn * g4[0] * siluf_(bflo(ogr[vt].x)), y1 = o[vt][1] * rn * g4[1] * siluf_(bfhi(ogr[vt].x)),
                                y2 = o[vt][2] * rn * g4[2] * siluf_(bflo(ogr[vt].y)), y3 = o[vt][3] * rn * g4[3] * siluf_(bfhi(ogr[vt].y));
                    w2[x].x = pk2(y0, y1); w2[x].y = pk2(y2, y3); }
                auto r0 = __builtin_amdgcn_permlane16_swap(w2[0].x, w2[1].x, false, false); auto r1 = __builtin_amdgcn_permlane16_swap(w2[0].y, w2[1].y, false, false);
                const int odd = q4 & 1;
                *(GAS v4u*)(Y + row_i * D + yc + 16 * (V0 + vp + odd) + 4 * (q4 - odd)) = (v4u){(unsigned)r0[0], (unsigned)r1[0], (unsigned)r0[1], (unsigned)r1[1]}; }
        }
        if (c + 1 < SEQ / 64) commit_qkz();
        lds_barrier();
        if (c + 1 < SEQ / 64) commit_v();
    }
}
__device__ __forceinline__ void p2_scan(Frame& F, int l) {
    for (int it = F.vcu; it < BATCH * 8; it += F.G) { const int b = it >> 3, u = it & 7;
        if (u < 4) scan_chunked<128, true>(F, l, b, u); else scan_chunked<64, false>(F, l, b, u - 4); }
    const bf16* proj = (const bf16*)(F.ws + WS_PROJ); bf16* Y = (bf16*)(F.ws + WS_Y);
    const GAS float* cw = inp(F, 9) + (size_t)l * 3 * 256;
    const bool even = (F.G == BATCH * 8); const bool isg = (F.vcu & 7) < 4; const int gi = (F.vcu >> 3) * 4 + ((F.vcu & 7) & 3);
    const long NCH = (long)M * 32 / 512, c_lo = even ? (isg ? 0 : CONV_GLA_CHUNKS) : 0, c_hi = even ? (isg ? CONV_GLA_CHUNKS : NCH) : NCH;
    const long cstart = (c_lo + (even ? gi : F.vcu)) * 512 + F.tid, cstride = (even ? 128L : (long)F.G) * 512;
    {
        const int ch = (int)(cstart & 31) * 8; const long cend = c_hi * 512;
        float cwr[3][8];
#pragma unroll
        for (int j = 0; j < 3; ++j)
#pragma unroll
            for (int q = 0; q < 8; ++q) cwr[j][q] = cw[256 * j + ch + q];
        v4u ccn[3], hhn[3], bbn;
        auto ld = [&](long idx) { const int row = (int)(idx >> 5), t = row & (SEQ - 1);
#pragma unroll
            for (int j = 0; j < 3; ++j) { const int dt = 2 - j; const int rr = (t - dt >= 0) ? row - dt : row;
                ccn[j] = *(const GAS v4u*)(proj + (size_t)rr * NPROJ_PAD + C_CC + ch); hhn[j] = *(const GAS v4u*)(proj + (size_t)rr * NPROJ_PAD + C_CH + ch); }
            bbn = *(const GAS v4u*)(proj + (size_t)row * NPROJ_PAD + C_CB + ch); };
        if (cstart < cend) ld(cstart);
#pragma unroll 1
        for (long idx = cstart; idx < cend; idx += cstride) { const int row = (int)(idx >> 5), t = row & (SEQ - 1);
            v4u cc[3], hh[3]; const v4u bb = bbn;
#pragma unroll
            for (int j = 0; j < 3; ++j) { cc[j] = ccn[j]; hh[j] = hhn[j]; }
            if (idx + cstride < cend) ld(idx + cstride);
            float o[8];
#pragma unroll
            for (int q = 0; q < 8; ++q) { float cv = 0.f;
#pragma unroll
                for (int j = 0; j < 3; ++j) { const unsigned cw2 = cc[j][q >> 1], hw2 = hh[j][q >> 1]; const float u = (q & 1) ? bfhi(cw2) * bfhi(hw2) : bflo(cw2) * bflo(hw2); cv += (t - (2 - j) >= 0) ? cwr[j][q] * u : 0.f; }
                const float bq = (q & 1) ? bfhi(bb[q >> 1]) : bflo(bb[q >> 1]); o[q] = bq * cv; }
            v4u w; w.x = pk2(o[0], o[1]); w.y = pk2(o[2], o[3]); w.z = pk2(o[4], o[5]); w.w = pk2(o[6], o[7]);
            *(GAS v4u*)(Y + (size_t)row * D + 768 + ch) = w; }
    }
}

constexpr int R_PITCH = 2064;
constexpr int R_HI = 0, R_LO = 16 * R_PITCH, R_PART = 2 * 16 * R_PITCH;
static_assert(R_PART + 8 * 16 * 32 * 4 <= RING_BYTES, "router LDS map");
__device__ __forceinline__ void p4_ln_router(Frame& F, int l) {
    LAS unsigned char* L = F.lds;
    LAS int* tokE = (LAS int*)(L + TOK_OFF); LAS int* tokP = tokE + 1024; LAS float* tokG = (LAS float*)(tokP + 1024);
    LAS int* lcnt = (LAS int*)(tokG + 1024); LAS int* gbase = lcnt + 32; LAS float* tokS = (LAS float*)(gbase + 32);
    const GAS float* Wr = inp(F, 13) + (size_t)l * D * NEXP; const GAS float* br = inp(F, 14) + l * NEXP;
    const GAS float* lng = inp(F, 11) + l * D; const GAS float* lnb = inp(F, 12) + l * D;
    GAS signed char* HQ = (GAS signed char*)(F.ws + WS_HB); GAS float* HS = (GAS float*)(F.ws + WS_HS);
    GAS int* slot_dst = (GAS int*)(F.ws + WS_SLOT); GAS float* slot_gate = (GAS float*)(F.ws + WS_SLOT + 8 * MiB); GAS float* slot_hs = (GAS float*)(F.ws + WS_SLOT + 16 * MiB);
    GAS bf16* MIX = (GAS bf16*)(F.ws + WS_MIX);
    gu32* gcnt = F.ctl + CW_CNT + l * 64;
    const int tid = F.tid, lane = F.lane, wave = F.wave, li = lane & 15, q4 = lane >> 4;
    bf16x8_t whi[4][2], wlo[4][2];
#pragma unroll
    for (int ks = 0; ks < 4; ++ks)
#pragma unroll
        for (int nt = 0; nt < 2; ++nt) { float w[8], wl[8];
#pragma unroll
            for (int j = 0; j < 8; ++j) { w[j] = Wr[(size_t)(128 * wave + 32 * ks + 8 * q4 + j) * NEXP + 16 * nt + li]; wl[j] = w[j] - bf2f((unsigned short)f2bf(w[j])); }
            v4u a, b; a.x = pk2(w[0], w[1]); a.y = pk2(w[2], w[3]); a.z = pk2(w[4], w[5]); a.w = pk2(w[6], w[7]); b.x = pk2(wl[0], wl[1]); b.y = pk2(wl[2], wl[3]); b.z = pk2(wl[4], wl[5]); b.w = pk2(wl[6], wl[7]);
            whi[ks][nt] = __builtin_bit_cast(bf16x8_t, a); wlo[ks][nt] = __builtin_bit_cast(bf16x8_t, b); }
    __syncthreads();
    for (int tb = F.vcu; tb < M / 256; tb += F.G) {
        if (tid < 32) lcnt[tid] = 0;
        v2u hA[2][4], mA[2][4], hB[2][4], mB[2][4];
#pragma unroll
        for (int r = 0; r < 2; ++r) { const size_t m0 = (size_t)(tb * 256 + 2 * wave + r); load_raw_q(hA[r], mA[r], HQ + m0 * D, HS + m0, MIX + m0 * D, lane);
            load_raw_q(hB[r], mB[r], HQ + (m0 + 16) * D, HS + m0 + 16, MIX + (m0 + 16) * D, lane); }
#pragma unroll 1
        for (int g2 = 0; g2 < 16; g2 += 2) {
#pragma unroll
          for (int par = 0; par < 2; ++par) { const int g = g2 + par;
            f32x4 v[2][4];
#pragma unroll
            for (int r = 0; r < 2; ++r) { if (par == 0) cvt_t_q(v[r], hA[r], mA[r]); else cvt_t_q(v[r], hB[r], mB[r]); }
            if (g + 2 < 16) {
#pragma unroll
                for (int r = 0; r < 2; ++r) { const size_t m0 = (size_t)(tb * 256 + (g + 2) * 16 + 2 * wave + r);
                    if (par == 0) load_raw_q(hA[r], mA[r], HQ + m0 * D, HS + m0, MIX + m0 * D, lane); else load_raw_q(hB[r], mB[r], HQ + m0 * D, HS + m0, MIX + m0 * D, lane); } }
            { const size_t m0 = (size_t)tb * 256 + g * 16 + 2 * wave; float sc0, sc1;
                ln_row2(v[0], v[1], lng, lnb, lane); store_row_q2(v[0], v[1], HQ + m0 * D, HQ + (m0 + 1) * D, HS + m0, HS + m0 + 1, lane, sc0, sc1);
                if (lane == 0) { tokS[g * 16 + 2 * wave] = sc0; tokS[g * 16 + 2 * wave + 1] = sc1; } }
#pragma unroll
            for (int r = 0; r < 2; ++r) { const int trow = 2 * wave + r;
#pragma unroll
                for (int j = 0; j < 4; ++j) { const f32x4 x = v[r][j]; v2u hi; hi.x = pk2(x.x, x.y); hi.y = pk2(x.z, x.w);
                    v2u lo; lo.x = pk2(x.x - bflo(hi.x), x.y - bfhi(hi.x)); lo.y = pk2(x.z - bflo(hi.y), x.w - bfhi(hi.y));
                    *(LAS v2u*)(L + R_HI + trow * R_PITCH + (4 * lane + 256 * j) * 2) = hi; *(LAS v2u*)(L + R_LO + trow * R_PITCH + (4 * lane + 256 * j) * 2) = lo; } }
            lds_barrier();
            f32x4 acc[2] = {(f32x4){0.f, 0.f, 0.f, 0.f}, (f32x4){0.f, 0.f, 0.f, 0.f}}, acb[2] = {(f32x4){0.f, 0.f, 0.f, 0.f}, (f32x4){0.f, 0.f, 0.f, 0.f}}, acc3[2] = {(f32x4){0.f, 0.f, 0.f, 0.f}, (f32x4){0.f, 0.f, 0.f, 0.f}};
            bf16x8_t ah[4], al[4];
#pragma unroll
            for (int ks = 0; ks < 4; ++ks) { ah[ks] = *(const LAS bf16x8_t*)(L + R_HI + li * R_PITCH + (128 * wave + 32 * ks + 8 * q4) * 2); al[ks] = *(const LAS bf16x8_t*)(L + R_LO + li * R_PITCH + (128 * wave + 32 * ks + 8 * q4) * 2); }
#pragma unroll
            for (int ks = 0; ks < 4; ++ks)
#pragma unroll
                for (int nt = 0; nt < 2; ++nt) { acc[nt] = __builtin_amdgcn_mfma_f32_16x16x32_bf16(ah[ks], whi[ks][nt], acc[nt], 0, 0, 0);
                    acb[nt] = __builtin_amdgcn_mfma_f32_16x16x32_bf16(al[ks], whi[ks][nt], acb[nt], 0, 0, 0); acc3[nt] = __builtin_amdgcn_mfma_f32_16x16x32_bf16(ah[ks], wlo[ks][nt], acc3[nt], 0, 0, 0); }
#pragma unroll
            for (int nt = 0; nt < 2; ++nt) acc[nt] = acc[nt] + (acb[nt] + acc3[nt]);
#pragma unroll
            for (int nt = 0; nt < 2; ++nt)
#pragma unroll
                for (int r = 0; r < 4; ++r) *(LAS float*)(L + R_PART + ((wave * 16 + 4 * q4 + r) * 32 + 16 * nt + li) * 4) = acc[nt][r];
            lds_barrier();
            { const int row = tid >> 5, e = tid & 31; float val = br[e];
#pragma unroll
                for (int w = 0; w < 8; ++w) val += *(const LAS float*)(L + R_PART + ((w * 16 + row) * 32 + e) * 4);
                float tv[4]; int te[4];
#pragma unroll
                for (int k = 0; k < 4; ++k) { float mx = val;
                    mx = fmaxf(mx, dpp_mv<0xb1, 0xf>(mx)); mx = fmaxf(mx, dpp_mv<0x4e, 0xf>(mx)); mx = fmaxf(mx, dpp_mv<0x124, 0xf>(mx)); mx = fmaxf(mx, dpp_mv<0x128, 0xf>(mx)); mx = xmax16(mx);
                    const unsigned long long bal = __ballot(val == mx); const unsigned hb32 = (unsigned)(bal >> (lane & 32)); const int es = __builtin_ctz(hb32);
                    tv[k] = mx; te[k] = es; if (e == es) val = -3.0e38f; }
                const float e1 = __expf(tv[1] - tv[0]), e2 = __expf(tv[2] - tv[0]), e3 = __expf(tv[3] - tv[0]); const float inv = 1.0f / (1.0f + e1 + e2 + e3);
                if (e < 4) { const int ek = e == 0 ? te[0] : e == 1 ? te[1] : e == 2 ? te[2] : te[3];
                    const float gk = (e == 0 ? 1.0f : e == 1 ? e1 : e == 2 ? e2 : e3) * inv; const int tl = g * 16 + row;
                    const int lp = __hip_atomic_fetch_add(lcnt + ek, 1, __ATOMIC_RELAXED, __HIP_MEMORY_SCOPE_WORKGROUP);
                    tokE[tl * 4 + e] = ek; tokP[tl * 4 + e] = lp; tokG[tl * 4 + e] = gk; } }
          }
        }
        __syncthreads();
        if (tid < 32) gbase[tid] = (int)__hip_atomic_fetch_add(gcnt + tid, (unsigned)lcnt[tid], RLX_AGENT);
        __syncthreads();
        for (int i = tid; i < 1024; i += 512) { const int e = tokE[i], pos = gbase[e] + tokP[i]; const size_t si = (size_t)e * CAP + pos;
            slot_dst[si] = (tb * 256 + (i >> 2)) * 4 + (i & 3); slot_gate[si] = tokG[i]; slot_hs[si] = tokS[i >> 2]; }
        __syncthreads();
    }
}

__device__ __forceinline__ int build_units(Frame& F, int l, int NT) {
    LAS int* list = (LAS int*)(F.lds + ULIST_OFF);
    gu32* gcnt = F.ctl + CW_CNT + l * 64;
    LAS int* cnts = (LAS int*)(F.lds + TOK_OFF);
    __syncthreads();
    if (F.tid < NEXP) cnts[F.tid] = (int)__hip_atomic_load(gcnt + F.tid, RLX_AGENT);
    __syncthreads();
    int nU = 0;
    {
        int tot = 0; for (int e = 0; e < NEXP; ++e) { const int c = cnts[e]; tot += ((c + 255) >> 8) * NT; }
        nU = (tot > F.vcu) ? (tot - F.vcu + F.G - 1) / F.G : 0; if (nU > 64) nU = 64;
        if (F.tid < nU) { const int q = F.tid * F.G + F.vcu; int base = 0, blk0 = 0, e = 0, c = 0, nb = 0;
            for (e = 0; e < NEXP; ++e) { c = cnts[e]; nb = (c + 255) >> 8; if (q < base + nb * NT) break; base += nb * NT; blk0 += nb; }
            const int lq = q - base, rg = lq / (8 * NT), l2 = lq % (8 * NT), gsz = (nb - 8 * rg) < 8 ? (nb - 8 * rg) : 8, pn = l2 / gsz, rb = 8 * rg + l2 % gsz;
            list[F.tid * 8 + 0] = blk0 + rb; list[F.tid * 8 + 1] = e * NT + pn; list[F.tid * 8 + 2] = e; list[F.tid * 8 + 3] = rb; list[F.tid * 8 + 4] = c; }
    }
    __syncthreads();
    return nU;
}


__device__ __forceinline__ void p7_combine(Frame& F, int l) {
    const int gw = F.vcu * NWAVES + F.wave, NGW = F.G * NWAVES, lane = F.lane;
    const GAS unsigned char* y4 = (const GAS unsigned char*)(F.ws + WS_Y4);
    GAS signed char* HQ = (GAS signed char*)(F.ws + WS_HB); GAS float* HS = (GAS float*)(F.ws + WS_HS);
    const GAS float* g2 = inp(F, 19) + l * D; const GAS float* b2 = inp(F, 20) + l * D;
    const bool lastl = (l == DEPTH - 1);
    for (int m = 4 * gw; m < M; m += 4 * NGW) {
        f32x4 v[4][4]; unsigned hv[4][4]; float hsa[4]; unsigned yv[4][4][4];
#pragma unroll
        for (int r = 0; r < 4; ++r) {
#pragma unroll
            for (int j = 0; j < 4; ++j) hv[r][j] = *(const GAS unsigned*)(HQ + (size_t)(m + r) * D + 4 * lane + 256 * j);
            hsa[r] = HS[m + r] * ALPHA;
#pragma unroll
            for (int k = 0; k < 4; ++k)
#pragma unroll
                for (int j = 0; j < 4; ++j) yv[r][k][j] = *(const GAS unsigned*)(y4 + ((size_t)(m + r) * 4 + k) * D + 4 * lane + 256 * j); }
#pragma unroll
        for (int r = 0; r < 4; ++r) {
#pragma unroll
            for (int j = 0; j < 4; ++j) { const int hw = (int)hv[r][j]; f32x4 a; a.x = (float)((hw << 24) >> 24) * hsa[r]; a.y = (float)((hw << 16) >> 24) * hsa[r]; a.z = (float)((hw << 8) >> 24) * hsa[r]; a.w = (float)(hw >> 24) * hsa[r];
                f32x4 ys = (f32x4){0.f, 0.f, 0.f, 0.f};
#pragma unroll
                for (int k = 0; k < 4; ++k) { const int w = (int)yv[r][k][j]; ys.x += __builtin_amdgcn_cvt_f32_fp8(w, 0); ys.y += __builtin_amdgcn_cvt_f32_fp8(w, 1); ys.z += __builtin_amdgcn_cvt_f32_fp8(w, 2); ys.w += __builtin_amdgcn_cvt_f32_fp8(w, 3); }
                v[r][j] = a + ys * (1.0f / 16.0f); }
            ln_row(v[r], g2, b2, lane);
            if (lastl) store_row_f(v[r], F.H + (size_t)(m + r) * D, lane);
            else store_row_q(v[r], HQ + (size_t)(m + r) * D, HS + m + r, lane); }
    }
}

struct Args { const float* in[21]; float* out; unsigned char* ws; int ph_lo, ph_hi; };
constexpr int N_PHASES = 2 + 7 * DEPTH;
__global__ void __launch_bounds__(NWAVES * 64, 2) fwd_kernel(Args args) {
    extern __shared__ __attribute__((aligned(16))) unsigned char lds[];
    Frame F;
    F.lds = (LAS unsigned char*)lds;
    F.MISC = (volatile LAS unsigned*)(F.lds + MISC_OFF);
    F.tid = threadIdx.x; F.lane = F.tid & 63; F.wave = __builtin_amdgcn_readfirstlane(F.tid >> 6);
    F.G = gridDim.x; { const int bx = blockIdx.x; F.vcu = (F.G % 8 == 0) ? (bx % 8) * (F.G / 8) + bx / 8 : bx; }
    F.ws = args.ws; F.ctl = (gu32*)(args.ws + WS_CTL); F.H = args.out;
    F.ka = (const __attribute__((address_space(4))) unsigned char*)__builtin_amdgcn_kernarg_segment_ptr();
    for (int u = F.tid; u < 64; u += NWAVES * 64) ((LAS unsigned*)(F.lds + MISC_OFF))[u] = 0u;
    __syncthreads();
#if MK_ONE_LAUNCH
    XcdBarrier bar = xcd_barrier_post((unsigned*)(F.ctl + CW_BAR), F.MISC + 8);
#define GRID_BAR() xcd_barrier(bar, F.tid == 0)
#else
#define GRID_BAR() do {} while (0)
#endif
#if MK_ONE_LAUNCH
    constexpr int lo = 0, hi = N_PHASES;
#else
    const int lo = args.ph_lo, hi = args.ph_hi;
#endif
#ifndef PH_MASK
#define PH_MASK 0xff
#endif
#define IN(k) (lo <= (k) && (k) < hi)
#define PHON(j) ((PH_MASK >> (j)) & 1)
#ifndef P7_DRY
#define P7_DRY 0
#endif
#ifndef P4_DRY
#define P4_DRY 0
#endif
#ifndef REP_MASK
#define REP_MASK 0
#endif
#define NREP(j) (((REP_MASK >> (j)) & 1) ? 2 : 1)
#define OPQ(p) do { unsigned _lo = (unsigned)(uintptr_t)(p), _hi = (unsigned)((uintptr_t)(p) >> 32); asm volatile("" : "+v"(_lo), "+v"(_hi)); _lo = __builtin_amdgcn_readfirstlane(_lo); _hi = __builtin_amdgcn_readfirstlane(_hi); \
        (p) = (decltype(p))(((uintptr_t)_hi << 32) | _lo); } while (0)
#define REFRESH() do { OPQ(F.ka); OPQ(F.ws); OPQ(F.H); F.lane = (int)__builtin_amdgcn_mbcnt_hi(~0u, __builtin_amdgcn_mbcnt_lo(~0u, 0u)); F.tid = (F.wave << 6) | F.lane; asm volatile("" : "+v"(F.tid)); F.lane = F.tid & 63; F.ctl = (gu32*)(F.ws + WS_CTL); F.lds = (LAS unsigned char*)lds; } while (0)
    if (PHON(0) && IN(1)) for (int rep = 0; rep < NREP(0); ++rep) { REFRESH(); p0_prologue(F); GRID_BAR(); }
#pragma unroll 1
    for (int l = 0; l < DEPTH; ++l) {
        const int pb = 2 + 7 * l;
        if (PHON(1) && IN(pb + 0)) for (int rep = 0; rep < NREP(1); ++rep) { REFRESH();
            pg8::Gemm g{(const bf16*)(F.ws + WS_HB), w_in_t(F, l), D}; pg8::StaticOrder S; S.init(M, NPROJ_PAD, F.G, (int)blockIdx.x);
            pg8::EpiProj E{(bf16*)(F.ws + WS_PROJ), NPROJ_PAD, (const GAS float*)(F.ws + WS_HS), (const GAS unsigned*)(F.ctl + CW_CMAX_IN + l * NPROJ_PAD)};
            pg8::gemm_phase<pg8::EpiProj, pg8::StaticOrder, false, 1>(F.lds, (LAS unsigned*)(F.lds + TOK_OFF), g, S, E, F.tid);
            GRID_BAR();
        }
        if (PHON(2) && IN(pb + 1)) for (int rep = 0; rep < NREP(2); ++rep) { REFRESH(); p2_scan(F, l); GRID_BAR(); }
        if (PHON(3) && IN(pb + 2)) { REFRESH();
            pg8::Gemm g{(const bf16*)(F.ws + WS_Y), w_out_t(F, l), D}; pg8::StaticOrder S; S.init(M, D, F.G, (int)blockIdx.x);
            pg8::EpiMix E{(bf16*)(F.ws + WS_MIX)};
            pg8::gemm_phase<pg8::EpiMix, pg8::StaticOrder, false, 0>(F.lds, (LAS unsigned*)(F.lds + TOK_OFF), g, S, E, F.tid);
            GRID_BAR();
        }
                if (PHON(4) && IN(pb + 3)) { REFRESH(); p4_ln_router(F, l); GRID_BAR(); }
        if (PHON(5) && IN(pb + 4)) for (int rep = 0; rep < NREP(5); ++rep) { REFRESH();
            const int nU = build_units(F, l, 8);
            pg8::Gemm g{(const bf16*)(F.ws + WS_HB), w_gu_t(F, l), D};
            pg8::ListOrder S{(const LAS int*)(F.lds + ULIST_OFF), nU, (const GAS int*)(F.ws + WS_SLOT), CAP, 1024u};
            pg8::EpiSwiglu E{(unsigned char*)(F.ws + WS_ACT), inp(F, 16) + (size_t)l * NEXP * 2048, (const GAS float*)(F.ws + WS_SLOT + 16 * MiB), (const GAS unsigned*)(F.ctl + CW_CMAX_GU + l * NEXP * 2048), CAP};
            pg8::gemm_phase<pg8::EpiSwiglu, pg8::ListOrder, true, 1>(F.lds, (LAS unsigned*)(F.lds + TOK_OFF), g, S, E, F.tid);
            GRID_BAR();
        }
        if (PHON(6) && IN(pb + 5)) for (int rep = 0; rep < NREP(6); ++rep) { REFRESH();
            const int nU = build_units(F, l, 4);
            pg8::Gemm g{(const bf16*)(F.ws + WS_ACT), w_dn_t(F, l), DFF};
            pg8::ListOrder S{(const LAS int*)(F.lds + ULIST_OFF), nU, (const GAS int*)(F.ws + WS_SLOT), CAP, 1024u};
            pg8::EpiDown E{(bf16*)(F.ws + WS_Y4), M * 4, inp(F, 18) + (size_t)l * NEXP * D, (const GAS int*)(F.ws + WS_SLOT), (const GAS float*)(F.ws + WS_SLOT + 8 * MiB), (const GAS unsigned*)(F.ctl + CW_CMAX_DN + l * NEXP * D), CAP};
            pg8::gemm_phase<pg8::EpiDown, pg8::ListOrder, false, 2>(F.lds, (LAS unsigned*)(F.lds + TOK_OFF), g, S, E, F.tid);
            GRID_BAR();
        }
        if (PHON(7) && IN(pb + 6)) { REFRESH(); p7_combine(F, l); if (l + 1 < DEPTH) GRID_BAR(); }
    }
#undef IN
}

extern "C" void kernel_launch(void* const* d_in, const int* in_sizes, int n_in, void* d_out, int out_size, void* d_ws, size_t ws_size, hipStream_t stream) {
    static int grid = 0;
    if (grid == 0) {
        if (n_in != 21 || in_sizes[0] != M * D || out_size != M * D || ws_size < WS_END) { fprintf(stderr, "kernel_launch: unexpected shapes (n_in %d, in0 %d, out %d, ws %zu)\n", n_in, n_in > 0 ? in_sizes[0] : -1, out_size, ws_size); grid = -1; return; }
        int dev = 0, cus = 0, per_cu = 0;
        if (hipGetDevice(&dev) != hipSuccess || hipDeviceGetAttribute(&cus, hipDeviceAttributeMultiprocessorCount, dev) != hipSuccess) { grid = -1; return; }
        if (hipFuncSetAttribute((const void*)fwd_kernel, hipFuncAttributeMaxDynamicSharedMemorySize, LDS_BYTES) != hipSuccess) { fprintf(stderr, "kernel_launch: hipFuncSetAttribute failed\n"); grid = -1; return; }
        if (hipOccupancyMaxActiveBlocksPerMultiprocessor(&per_cu, (const void*)fwd_kernel, NWAVES * 64, LDS_BYTES) != hipSuccess || per_cu < 1) fprintf(stderr, "kernel_launch: occupancy query says %d\n", per_cu);
        (void)hipGetLastError();
        grid = cus;
    }
    if (grid < 0) return;
    if (hipMemsetAsync((char*)d_ws + WS_CTL, 0, 128 * 1024, stream) != hipSuccess) return;
    Args a{};
    for (int i = 0; i < 21; ++i) a.in[i] = (const float*)d_in[i];
    a.out = (float*)d_out; a.ws = (unsigned char*)d_ws;
#if MK_ONE_LAUNCH
    a.ph_lo = 0; a.ph_hi = N_PHASES;
    hipLaunchKernelGGL(fwd_kernel, dim3(grid), dim3(NWAVES * 64), LDS_BYTES, stream, a);
#else
    for (int p = 0; p < N_PHASES; ++p) { a.ph_lo = p; a.ph_hi = p + 1; hipLaunchKernelGGL(fwd_kernel, dim3(grid), dim3(NWAVES * 64), LDS_BYTES, stream, a); }
#endif
}
```

```cpp
#include <hip/hip_runtime.h>
#include <cstdio>
#include <cstdint>

#ifndef CONV_GLA_CHUNKS
#define CONV_GLA_CHUNKS 768
#endif
#ifndef MK_ONE_LAUNCH
#define MK_ONE_LAUNCH 1
#endif

#define GAS __attribute__((address_space(1)))
#define LAS __attribute__((address_space(3)))
namespace pg8 {
#define PG8_LAS __attribute__((address_space(3)))
typedef unsigned short bf16_t;
typedef short bf16x8 __attribute__((ext_vector_type(8)));
typedef float f32x4 __attribute__((ext_vector_type(4)));
typedef unsigned u32x4 __attribute__((ext_vector_type(4)));
typedef int i32x4 __attribute__((ext_vector_type(4)));
constexpr int BM = 256, BK = 64, HALF = 128, HTB = HALF * BK * 2, STAGE_BYTES = 8 * HTB, NXCD = 8, WGM = 8;

__host__ __device__ __forceinline__ int lds_byte(int r, int c) { const int st = (r >> 4) * 2 + (c >> 5), rr = r & 15, cc = c & 31, ob = rr * 64 + cc * 2; return st * 1024 + (ob ^ (((ob >> 9) & 1) << 5)); }
__host__ __device__ __forceinline__ void stage_rc(int b, int& R, int& C) { const int st = b / 1024, sb = b % 1024, swz = sb ^ (((sb >> 9) & 1) << 5); R = (st >> 1) * 16 + swz / 64; C = (st & 1) * 32 + (swz % 64) / 2; }
__host__ __device__ __forceinline__ int perm32(int rho) { const int n = rho >> 4, i = rho & 15; return 8 * (i >> 2) + 4 * n + (i & 3); }

struct Unit { int pm, pn, e, rb, cnt; };
struct Gemm { const bf16_t* A; const bf16_t* Bt; int K; };

struct StaticOrder {
    int nM, nN, nwg, G, c;
    __device__ void init(int M, int N, int G_, int c_) { nM = M / BM; nN = N / BM; nwg = nM * nN; G = G_; c = c_; }
    __device__ __forceinline__ bool next(int i, Unit& u) const {
        const long L = (long)i * G + c; if (L >= nwg) return false;
        int wgid = (int)L; { const int q = nwg / NXCD, r = nwg % NXCD, xcd = wgid % NXCD, off = wgid / NXCD; wgid = (xcd < r ? xcd * (q + 1) : r * (q + 1) + (xcd - r) * q) + off; }
        const int nig = WGM * nN, gid = wgid / nig, fm = gid * WGM, gsz = (nM - fm) < WGM ? (nM - fm) : WGM;
        u.pm = fm + ((wgid % nig) % gsz); u.pn = (wgid % nig) / gsz; u.e = 0; u.rb = 0; u.cnt = 0; return true;
    }
    __device__ __forceinline__ unsigned row_off(const Unit&, int, int) const { return 0u; }
    __device__ __forceinline__ const int* gsrc() const { return nullptr; }
    __device__ __forceinline__ unsigned gsoff(const Unit&) const { return 0u; }
    __device__ __forceinline__ unsigned raw_off(const Unit&, int, int, unsigned) const { return 0u; }
};
struct ListOrder {
    const PG8_LAS int* list; int n;
    const GAS int* slot_dst; int cap; unsigned rowbytes;
    __device__ __forceinline__ bool next(int i, Unit& u) const {
        if (i >= n) return false;
        const PG8_LAS int* p = list + i * 8;
        u.pm = __builtin_amdgcn_readfirstlane(p[0]); u.pn = __builtin_amdgcn_readfirstlane(p[1]); u.e = __builtin_amdgcn_readfirstlane(p[2]);
        u.rb = __builtin_amdgcn_readfirstlane(p[3]); u.cnt = __builtin_amdgcn_readfirstlane(p[4]); return true;
    }
    __device__ __forceinline__ unsigned row_off(const Unit& u, int h, int R) const {
        const int pos = u.rb * 256 + h * 128 + R;
        int tok = 0; if (pos < u.cnt) tok = slot_dst[(size_t)u.e * cap + pos] >> 2;
        return (unsigned)tok * rowbytes;
    }
    __device__ __forceinline__ const int* gsrc() const { return (const int*)slot_dst; }
    __device__ __forceinline__ unsigned gsoff(const Unit& u) const { return (unsigned)u.e * (unsigned)cap * 4u; }
    __device__ __forceinline__ unsigned raw_off(const Unit& u, int h, int R, unsigned raw) const { const int pos = u.rb * 256 + h * 128 + R; return (pos < u.cnt ? (raw >> 2) : 0u) * rowbytes; }
};

typedef float f32x2c __attribute__((ext_vector_type(2)));
typedef __bf16 bf16x2c __attribute__((ext_vector_type(2)));
__device__ __forceinline__ unsigned cvt_pk_bf16(float lo, float hi) { const f32x2c v = {lo, hi}; const bf16x2c b = __builtin_convertvector(v, bf16x2c); return __builtin_bit_cast(unsigned, b); }

struct Pre2 { unsigned a, b; };
__device__ __forceinline__ unsigned pack_i8x4(float x0, float x1, float x2, float x3) {
    const unsigned y0 = __float_as_uint(x0 + 12582912.0f), y1 = __float_as_uint(x1 + 12582912.0f), y2 = __float_as_uint(x2 + 12582912.0f), y3 = __float_as_uint(x3 + 12582912.0f);
    return (y0 & 0xffu) | ((y1 & 0xffu) << 8) | ((y2 & 0xffu) << 16) | (y3 << 24);
}
struct EpiProj {
    static constexpr bool PERM = true, HAS_PRE = true; static constexpr int NVM = 16; typedef Pre2 Pre;
    bf16_t* O; int ldc; const GAS float* hs; const GAS unsigned* cmax;
    __device__ __forceinline__ Pre2 prefetch(const Unit& u, int t) const { Pre2 p; p.b = 0u;
        p.a = t < 256 ? __float_as_uint(hs[u.pm * BM + t]) : cmax[u.pn * BM + (t - 256)]; return p; }
    __device__ __forceinline__ void stash(const Pre2& p, PG8_LAS unsigned* scr, int t) const { scr[t] = p.a; }
    __device__ __forceinline__ void operator()(const i32x4 (&acc)[2][2][4][2], const Unit& u, int wr, int wc, int fr, int fq, PG8_LAS unsigned* scr) const {
        const int row0 = u.pm * BM + wr * 64 + fr, col0 = u.pn * BM + wc * 32 + 8 * fq;
        f32x4 cs[2][2];
#pragma unroll
        for (int bj = 0; bj < 2; ++bj)
#pragma unroll
            for (int n = 0; n < 2; ++n) cs[bj][n] = *(const PG8_LAS f32x4*)(scr + 256 + bj * HALF + wc * 32 + 8 * fq + 4 * n) * (1.0f / 127.0f);
#pragma unroll
        for (int ai = 0; ai < 2; ++ai)
#pragma unroll
            for (int m = 0; m < 4; ++m) { const int r = ai * HALF + wr * 64 + m * 16 + fr; const float rs = __uint_as_float(scr[r]); bf16_t* rowp = O + (size_t)(u.pm * BM + r) * ldc + col0;
#pragma unroll
                for (int bj = 0; bj < 2; ++bj) { const f32x4 v0 = __builtin_convertvector(acc[ai][bj][m][0], f32x4) * (cs[bj][0] * rs), v1 = __builtin_convertvector(acc[ai][bj][m][1], f32x4) * (cs[bj][1] * rs);
                    u32x4 w; w.x = cvt_pk_bf16(v0[0], v0[1]); w.y = cvt_pk_bf16(v0[2], v0[3]); w.z = cvt_pk_bf16(v1[0], v1[1]); w.w = cvt_pk_bf16(v1[2], v1[3]);
                    *(GAS u32x4*)(rowp + bj * HALF) = w; } }
        (void)row0;
    }
};
struct EpiMix {
    static constexpr bool PERM = true, HAS_PRE = false; static constexpr int NVM = 16; typedef Pre2 Pre;
    bf16_t* O;
    __device__ __forceinline__ Pre2 prefetch(const Unit&, int) const { return Pre2{0u, 0u}; }
    __device__ __forceinline__ void stash(const Pre2&, PG8_LAS unsigned*, int) const {}
    __device__ __forceinline__ void operator()(const f32x4 (&acc)[2][2][4][2], const Unit& u, int wr, int wc, int fr, int fq, PG8_LAS unsigned*) const {
        const int row0 = u.pm * BM + wr * 64 + fr, col0 = u.pn * BM + wc * 32 + 8 * fq;
#pragma unroll
        for (int ai = 0; ai < 2; ++ai)
#pragma unroll
            for (int m = 0; m < 4; ++m) { bf16_t* rowp = O + (size_t)(row0 + ai * HALF + m * 16) * 1024 + col0;
#pragma unroll
                for (int bj = 0; bj < 2; ++bj) { const f32x4 v0 = acc[ai][bj][m][0], v1 = acc[ai][bj][m][1];
                    u32x4 w; w.x = cvt_pk_bf16(v0[0], v0[1]); w.y = cvt_pk_bf16(v0[2], v0[3]); w.z = cvt_pk_bf16(v1[0], v1[1]); w.w = cvt_pk_bf16(v1[2], v1[3]);
                    *(GAS u32x4*)(rowp + bj * HALF) = w; } }
    }
};
constexpr float ACT_SC = 8.0f;
struct EpiSwiglu {
    static constexpr bool PERM = true, HAS_PRE = true; static constexpr int NVM = 4; typedef Pre2 Pre;
    unsigned char* act; const GAS float* bgu; const GAS float* slot_hs; const GAS unsigned* cmax; int cap;
    __device__ __forceinline__ Pre2 prefetch(const Unit& u, int t) const { Pre2 p; const int j = u.pn & 7;
        if (t < 256) { p.a = __float_as_uint(slot_hs[(size_t)u.e * cap + u.rb * 256 + t]); p.b = __float_as_uint(bgu[(size_t)u.e * 2048 + (t < 128 ? j * 128 + t : 1024 + j * 128 + (t - 128))]); }
        else { p.a = cmax[(size_t)u.e * 2048 + j * 256 + (t - 256)]; p.b = 0u; }
        return p; }
    __device__ __forceinline__ void stash(const Pre2& p, PG8_LAS unsigned* scr, int t) const { scr[t] = p.a; if (t < 256) scr[512 + t] = p.b; }
    __device__ __forceinline__ void operator()(const i32x4 (&acc)[2][2][4][2], const Unit& u, int wr, int wc, int fr, int fq, PG8_LAS unsigned* scr) const {
        const int j = u.pn & 7;
        const int row0 = u.pm * BM + wr * 64 + fr, c0 = j * 128 + wc * 32 + 8 * fq, cl = wc * 32 + 8 * fq;
        f32x4 bgv[2], buv[2], csg[2], csu[2];
        constexpr float C2 = 1.702f * 1.44269504f;
#pragma unroll
        for (int n = 0; n < 2; ++n) { bgv[n] = *(const PG8_LAS f32x4*)(scr + 512 + cl + 4 * n) * C2; buv[n] = *(const PG8_LAS f32x4*)(scr + 512 + 128 + cl + 4 * n);
            csg[n] = *(const PG8_LAS f32x4*)(scr + 256 + cl + 4 * n) * (C2 / 127.0f); csu[n] = *(const PG8_LAS f32x4*)(scr + 256 + 128 + cl + 4 * n) * (1.0f / 127.0f); }
#pragma unroll
        for (int ai = 0; ai < 2; ++ai)
#pragma unroll
            for (int mp = 0; mp < 4; mp += 2) { unsigned wp[2][2];
#pragma unroll
                for (int hm = 0; hm < 2; ++hm) { const int m = mp + hm; const int r = ai * HALF + wr * 64 + m * 16 + fr; const float rs = __uint_as_float(scr[r]); float o[8];
#pragma unroll
                    for (int n = 0; n < 2; ++n) { const f32x4 sgr = csg[n] * rs, sur = csu[n] * rs;
#pragma unroll
                        for (int q = 0; q < 4; ++q) { const float h = fminf(__builtin_fmaf((float)acc[ai][0][m][n][q], sgr[q], bgv[n][q]), 7.0f * C2), up = fminf(fmaxf(__builtin_fmaf((float)acc[ai][1][m][n][q], sur[q], buv[n][q]), -7.0f), 7.0f);
                            const float sg = __builtin_amdgcn_rcpf(1.0f + __builtin_amdgcn_exp2f(-h)); o[4 * n + q] = __builtin_fmaf(up, ACT_SC / C2, ACT_SC / C2) * (h * sg); } }
                    int w0 = __builtin_amdgcn_cvt_pk_fp8_f32(o[0], o[1], 0, false); w0 = __builtin_amdgcn_cvt_pk_fp8_f32(o[2], o[3], w0, true);
                    int w1 = __builtin_amdgcn_cvt_pk_fp8_f32(o[4], o[5], 0, false); w1 = __builtin_amdgcn_cvt_pk_fp8_f32(o[6], o[7], w1, true);
                    wp[hm][0] = (unsigned)w0; wp[hm][1] = (unsigned)w1; }
                { auto r0 = __builtin_amdgcn_permlane16_swap(wp[0][0], wp[1][0], false, false); wp[0][0] = r0[0]; wp[1][0] = r0[1];
                  auto r1 = __builtin_amdgcn_permlane16_swap(wp[0][1], wp[1][1], false, false); wp[0][1] = r1[0]; wp[1][1] = r1[1]; }
                const int odd = fq & 1;
                const size_t arow = (size_t)(row0 + ai * HALF + (mp + odd) * 16);
                *(GAS u32x4*)(act + arow * 1024 + (c0 - 8 * odd)) = (u32x4){wp[0][0], wp[0][1], wp[1][0], wp[1][1]};
                __builtin_amdgcn_sched_barrier(0); }
    }
};
struct Pre3 { unsigned a, b, c; };
constexpr float WDN_SC = 447.0f;
struct EpiDown {
    static constexpr bool PERM = true, HAS_PRE = true; static constexpr int NVM = 8; typedef Pre3 Pre;
    bf16_t* y4; int trash; const GAS float* bdn; const GAS int* slot_dst; const GAS float* slot_gate; const GAS unsigned* cmax; int cap;
    __device__ __forceinline__ Pre3 prefetch(const Unit& u, int t) const { Pre3 p;
        if (t < 256) { const size_t si = (size_t)u.e * cap + u.rb * 256 + t; p.a = (unsigned)slot_dst[si]; p.b = __float_as_uint(slot_gate[si]); p.c = 0u; }
        else { p.a = __float_as_uint(bdn[(size_t)u.e * 1024 + (u.pn & 3) * 256 + (t - 256)]); p.b = cmax[(size_t)u.e * 1024 + (u.pn & 3) * 256 + (t - 256)]; p.c = 0u; }
        return p; }
    __device__ __forceinline__ void stash(const Pre3& p, PG8_LAS unsigned* scr, int t) const { scr[t] = p.a; scr[512 + t] = p.b; }
    __device__ __forceinline__ void operator()(const f32x4 (&acc)[2][2][4][2], const Unit& u, int wr, int wc, int fr, int fq, PG8_LAS unsigned* scr) const {
        const int jn = u.pn & 3;
        const int c0 = jn * 256 + wc * 32 + 8 * fq, cl = wc * 32 + 8 * fq;
        f32x4 bv[2][2], cs[2][2];
#pragma unroll
        for (int bj = 0; bj < 2; ++bj)
#pragma unroll
            for (int n = 0; n < 2; ++n) { bv[bj][n] = *(const PG8_LAS f32x4*)(scr + 256 + bj * HALF + cl + 4 * n); cs[bj][n] = *(const PG8_LAS f32x4*)(scr + 768 + bj * HALF + cl + 4 * n) * (1.0f / (WDN_SC * ACT_SC)); }
#pragma unroll
        for (int ai = 0; ai < 2; ++ai)
#pragma unroll
            for (int mp = 0; mp < 4; mp += 2) { unsigned wq[2][2][2]; int dsts[2];
#pragma unroll
                for (int hm = 0; hm < 2; ++hm) { const int m = mp + hm; const int r = ai * HALF + wr * 64 + m * 16 + fr; const int pos = u.rb * 256 + r;
                    dsts[hm] = pos < u.cnt ? (int)scr[r] : trash + r; const float rg = __uint_as_float(scr[512 + r]) * 16.0f;
#pragma unroll
                    for (int bj = 0; bj < 2; ++bj) { f32x4 v0 = (acc[ai][bj][m][0] * cs[bj][0] + bv[bj][0]) * rg, v1 = (acc[ai][bj][m][1] * cs[bj][1] + bv[bj][1]) * rg;
#pragma unroll
                        for (int q = 0; q < 4; ++q) { v0[q] = fminf(fmaxf(v0[q], -448.0f), 448.0f); v1[q] = fminf(fmaxf(v1[q], -448.0f), 448.0f); }
                        int w0 = __builtin_amdgcn_cvt_pk_fp8_f32(v0[0], v0[1], 0, false); w0 = __builtin_amdgcn_cvt_pk_fp8_f32(v0[2], v0[3], w0, true);
                        int w1 = __builtin_amdgcn_cvt_pk_fp8_f32(v1[0], v1[1], 0, false); w1 = __builtin_amdgcn_cvt_pk_fp8_f32(v1[2], v1[3], w1, true);
                        wq[hm][bj][0] = (unsigned)w0; wq[hm][bj][1] = (unsigned)w1; } }
                const int odd = fq & 1; unsigned char* rowp = (unsigned char*)y4 + (size_t)(odd ? dsts[1] : dsts[0]) * 1024 + (c0 - 8 * odd);
#pragma unroll
                for (int bj = 0; bj < 2; ++bj) {
                    auto r0 = __builtin_amdgcn_permlane16_swap(wq[0][bj][0], wq[1][bj][0], false, false); auto r1 = __builtin_amdgcn_permlane16_swap(wq[0][bj][1], wq[1][bj][1], false, false);
                    *(GAS u32x4*)(rowp + bj * HALF) = (u32x4){(unsigned)r0[0], (unsigned)r1[0], (unsigned)r0[1], (unsigned)r1[1]}; } }
    }
};

template <int MODE> struct AccOf { typedef f32x4 type; };
template <> struct AccOf<1> { typedef i32x4 type; };
__device__ __forceinline__ f32x4 mma16(bf16x8 a, bf16x8 b, f32x4 c) { asm volatile("v_mfma_f32_16x16x32_bf16 %0, %1, %2, %0" : "+v"(c) : "v"(a), "v"(b)); return c; }
__device__ __forceinline__ i32x4 mma16(bf16x8 a, bf16x8 b, i32x4 c) { asm volatile("v_mfma_i32_16x16x64_i8 %0, %1, %2, %0" : "+v"(c) : "v"(a), "v"(b)); return c; }
typedef int i32x8 __attribute__((ext_vector_type(8)));
__device__ __forceinline__ f32x4 mma128(bf16x8 a0, bf16x8 a1, bf16x8 b0, bf16x8 b1, f32x4 c) {
    const i32x8 a = __builtin_shufflevector(__builtin_bit_cast(i32x4, a0), __builtin_bit_cast(i32x4, a1), 0, 1, 2, 3, 4, 5, 6, 7), b = __builtin_shufflevector(__builtin_bit_cast(i32x4, b0), __builtin_bit_cast(i32x4, b1), 0, 1, 2, 3, 4, 5, 6, 7);
    asm volatile("v_mfma_f32_16x16x128_f8f6f4 %0, %1, %2, %0" : "+v"(c) : "v"(a), "v"(b)); return c;
}
__device__ __forceinline__ f32x4 mma16z(bf16x8 a, bf16x8 b, f32x4) { f32x4 c; asm volatile("v_mfma_f32_16x16x32_bf16 %0, %1, %2, 0" : "=&v"(c) : "v"(a), "v"(b)); return c; }
__device__ __forceinline__ i32x4 mma16z(bf16x8 a, bf16x8 b, i32x4) { i32x4 c; asm volatile("v_mfma_i32_16x16x64_i8 %0, %1, %2, 0" : "=&v"(c) : "v"(a), "v"(b)); return c; }
__device__ __forceinline__ f32x4 mma128z(bf16x8 a0, bf16x8 a1, bf16x8 b0, bf16x8 b1) {
    const i32x8 a = __builtin_shufflevector(__builtin_bit_cast(i32x4, a0), __builtin_bit_cast(i32x4, a1), 0, 1, 2, 3, 4, 5, 6, 7), b = __builtin_shufflevector(__builtin_bit_cast(i32x4, b0), __builtin_bit_cast(i32x4, b1), 0, 1, 2, 3, 4, 5, 6, 7);
    f32x4 c; asm volatile("v_mfma_f32_16x16x128_f8f6f4 %0, %1, %2, 0" : "=&v"(c) : "v"(a), "v"(b)); return c;
}
template <class Epi, class Sched, bool GATHER, int MODE>
__device__ __forceinline__ void gemm_phase(PG8_LAS unsigned char* lds, PG8_LAS unsigned* scr, const Gemm g, const Sched& S, const Epi& E, int tid_in) {
    int tid = tid_in; asm volatile("" : "+v"(tid));
    const int wid = __builtin_amdgcn_readfirstlane(tid >> 6), lane = tid & 63, wr = wid >> 2, wc = wid & 3, fr = lane & 15, fq = lane >> 4;
    constexpr int K = MODE ? 512 : 1024, nt = K / BK;
    unsigned voffA[2], voffB[2];
#pragma unroll
    for (int i = 0; i < 2; ++i) { int R, C; stage_rc(tid * 16 + i * 8192, R, C); const int Rb = Epi::PERM ? ((R & ~31) + perm32(R & 31)) : R;
        voffA[i] = (unsigned)(R * K + C) * 2u; voffB[i] = (unsigned)(Rb * K + C) * 2u; }
    auto gather4 = [&](const Unit& uu) { u32x4 o; int tz = tid; asm volatile("" : "+v"(tz));
#pragma unroll
        for (int i = 0; i < 2; ++i) { int R, C; stage_rc(tz * 16 + i * 8192, R, C); o[i] = S.row_off(uu, 0, R) + (unsigned)C * 2u; o[2 + i] = S.row_off(uu, 1, R) + (unsigned)C * 2u; }
        return o; };
    auto gather_issue = [&](const Unit& uu) { int tz = tid; asm volatile("" : "+v"(tz));
        const __amdgpu_buffer_rsrc_t rs = __builtin_amdgcn_make_buffer_rsrc((void*)S.gsrc(), 0, (int)0xFFFFFFFFu, 0x00020000); const unsigned so = S.gsoff(uu);
#pragma unroll
        for (int i = 0; i < 2; ++i) { int R, C; stage_rc(tz * 16 + i * 8192, R, C);
#pragma unroll
            for (int h = 0; h < 2; ++h) __builtin_amdgcn_raw_ptr_buffer_load_lds(rs, (PG8_LAS void*)((PG8_LAS unsigned char*)(scr + 1024) + (2 * h + i) * 2048 + wid * 256), 4, (int)((unsigned)(uu.rb * 256 + h * 128 + R) * 4u), (int)so, 0, 0); } };
    auto gather_read = [&](const Unit& uu) { u32x4 o; int tz = tid; asm volatile("" : "+v"(tz));
#pragma unroll
        for (int i = 0; i < 2; ++i) { int R, C; stage_rc(tz * 16 + i * 8192, R, C);
#pragma unroll
            for (int h = 0; h < 2; ++h) o[2 * h + i] = S.raw_off(uu, h, R, *((const PG8_LAS unsigned*)(scr + 1024) + (2 * h + i) * 512 + tz)) + (unsigned)C * 2u; }
        return o; };
    constexpr unsigned kstep = (unsigned)(BK * 2);
    constexpr unsigned hstep = (unsigned)HALF * K * 2;
    constexpr unsigned tstep = 2 * hstep;
    constexpr unsigned hstepA = GATHER ? 0u : hstep;
    const __amdgpu_buffer_rsrc_t baseA = __builtin_amdgcn_make_buffer_rsrc((void*)g.A, 0, (int)0xFFFFFFFFu, 0x00020000), baseB = __builtin_amdgcn_make_buffer_rsrc((void*)g.Bt, 0, (int)0xFFFFFFFFu, 0x00020000);
    const unsigned ldsw = (unsigned)wid * 1024u;
    const int aoff = lds_byte(wr * 64 + fr, fq * 8), boff = lds_byte(wc * 32 + fr, fq * 8);
#define PG8_SA(b, h) (((b) * 2 + (h)) * HTB)
#define PG8_SB(b, h) ((4 + (b) * 2 + (h)) * HTB)
#define PG8_STAGE(bufoff, base, uoff, voff) do { _Pragma("unroll") for (int _i = 0; _i < 2; ++_i) \
        __builtin_amdgcn_raw_ptr_buffer_load_lds((base), (PG8_LAS void*)(lds + (bufoff) + ldsw + _i * 8192), 16, (int)(voff)[_i], (int)(uoff), 0, 0); } while (0)
#define PG8_LDA(dst, b, h) do { _Pragma("unroll") for (int m = 0; m < 4; ++m) _Pragma("unroll") for (int k = 0; k < 2; ++k) dst[m][k] = *(const PG8_LAS bf16x8*)(lds + PG8_SA(b, h) + aoff + m * 2048 + k * 1024); } while (0)
#define PG8_LDB(dst, b, h) do { _Pragma("unroll") for (int n = 0; n < 2; ++n) _Pragma("unroll") for (int k = 0; k < 2; ++k) dst[n][k] = *(const PG8_LAS bf16x8*)(lds + PG8_SB(b, h) + boff + n * 2048 + k * 1024); } while (0)
#define PG8_MMA(ai, bj, At, Bt) do { __builtin_amdgcn_s_setprio(1); _Pragma("unroll") for (int m = 0; m < 4; ++m) _Pragma("unroll") for (int n = 0; n < 2; ++n) { \
        if constexpr (MODE == 2) acc[ai][bj][m][n] = mma128(Bt[n][0], Bt[n][1], At[m][0], At[m][1], acc[ai][bj][m][n]); \
        else { _Pragma("unroll") for (int k = 0; k < 2; ++k) acc[ai][bj][m][n] = mma16(Bt[n][k], At[m][k], acc[ai][bj][m][n]); } } __builtin_amdgcn_s_setprio(0); } while (0)
#define PG8_MMAZ(ai, bj, At, Bt) do { __builtin_amdgcn_s_setprio(1); _Pragma("unroll") for (int m = 0; m < 4; ++m) _Pragma("unroll") for (int n = 0; n < 2; ++n) { \
        if constexpr (MODE == 2) acc[ai][bj][m][n] = mma128z(Bt[n][0], Bt[n][1], At[m][0], At[m][1]); \
        else { acc[ai][bj][m][n] = mma16z(Bt[n][0], At[m][0], acc[ai][bj][m][n]); acc[ai][bj][m][n] = mma16(Bt[n][1], At[m][1], acc[ai][bj][m][n]); } } __builtin_amdgcn_s_setprio(0); } while (0)
#define PG8_WAIT_V(n) asm volatile("s_waitcnt vmcnt(" #n ")" ::: "memory")
#define PG8_WAIT_VN(n) asm volatile("s_waitcnt vmcnt(%0)" :: "n"(n) : "memory")
#define PG8_WAIT_L(n) asm volatile("s_waitcnt lgkmcnt(" #n ")" ::: "memory")
#define PG8_BAR __builtin_amdgcn_s_barrier()
#define PG8_SCHED __builtin_amdgcn_sched_barrier(0)
    Unit cur, nxt; int ui = 0;
    if (!S.next(0, cur)) return;
    typedef typename AccOf<MODE>::type AccT;
    AccT acc[2][2][4][2];
    bf16x8 At[4][2], B0[2][2], B1[2][2];
    unsigned c0[2], c1[2];
    if (GATHER) { gather_issue(cur); asm volatile("s_waitcnt vmcnt(0)" ::: "memory");
        const u32x4 o = gather_read(cur); c0[0] = o[0]; c0[1] = o[1]; c1[0] = o[2]; c1[1] = o[3]; }
    else { c0[0] = voffA[0]; c0[1] = voffA[1]; c1[0] = voffA[0]; c1[1] = voffA[1]; }
    unsigned cA = GATHER ? 0u : (unsigned)cur.pm * tstep, cB = (unsigned)cur.pn * tstep;
    PG8_STAGE(PG8_SB(0, 0), baseB, cB, voffB); PG8_STAGE(PG8_SB(0, 1), baseB, cB + hstep, voffB); PG8_STAGE(PG8_SA(0, 0), baseA, cA, c0); PG8_STAGE(PG8_SA(0, 1), baseA, cA + hstepA, c1);
    if (wr == 1) PG8_BAR;
    PG8_WAIT_V(2); PG8_BAR;
    PG8_STAGE(PG8_SB(1, 0), baseB, cB + kstep, voffB); PG8_STAGE(PG8_SA(1, 0), baseA, cA + kstep, c0); PG8_STAGE(PG8_SB(1, 1), baseB, cB + hstep + kstep, voffB);
    PG8_WAIT_V(6); PG8_BAR;
    for (;;) {
        const typename Epi::Pre pre = E.prefetch(cur, tid);
        const bool has_next = S.next(ui + 1, nxt);
        const unsigned nA = has_next ? (GATHER ? 0u : (unsigned)nxt.pm * tstep) : cA, nB = has_next ? (unsigned)nxt.pn * tstep : cB;
        if (GATHER && has_next) gather_issue(nxt);
        {
            const unsigned a1 = cA + kstep, a2 = cA + 2u * kstep, b2 = cB + 2u * kstep, a3 = a2 + kstep, b3 = b2 + kstep;
            PG8_LDB(B0, 0, 0); PG8_LDB(B1, 0, 1); PG8_SCHED; PG8_LDA(At, 0, 0); PG8_STAGE(PG8_SA(1, 1), baseA, a1 + hstepA, c1);
            if (ui > 0) PG8_WAIT_VN(8 + Epi::NVM); else PG8_WAIT_V(8);
            PG8_WAIT_L(0); PG8_BAR; PG8_MMAZ(0, 0, At, B0); PG8_MMAZ(0, 1, At, B1); PG8_BAR; PG8_SCHED;
            PG8_LDA(At, 0, 1); PG8_STAGE(PG8_SB(0, 0), baseB, b2, voffB); PG8_STAGE(PG8_SB(0, 1), baseB, b2 + hstep, voffB); PG8_STAGE(PG8_SA(0, 0), baseA, a2, c0);
            if (ui > 0) PG8_WAIT_VN(8 + Epi::NVM); else PG8_WAIT_V(8);
            PG8_WAIT_L(0); PG8_BAR; PG8_MMAZ(1, 0, At, B0); PG8_MMAZ(1, 1, At, B1); PG8_BAR; PG8_SCHED;
            PG8_LDB(B0, 1, 0); PG8_LDB(B1, 1, 1); PG8_SCHED; PG8_LDA(At, 1, 0); PG8_STAGE(PG8_SA(0, 1), baseA, a2 + hstepA, c1);
            PG8_WAIT_V(8); PG8_WAIT_L(0); PG8_BAR; PG8_MMA(0, 0, At, B0); PG8_MMA(0, 1, At, B1); PG8_BAR; PG8_SCHED;
            PG8_LDA(At, 1, 1); PG8_STAGE(PG8_SB(1, 0), baseB, b3, voffB); PG8_STAGE(PG8_SB(1, 1), baseB, b3 + hstep, voffB); PG8_STAGE(PG8_SA(1, 0), baseA, a3, c0);
            PG8_WAIT_V(8); PG8_WAIT_L(0); PG8_BAR; PG8_MMA(1, 0, At, B0); PG8_MMA(1, 1, At, B1); PG8_BAR; PG8_SCHED;
        }
#pragma unroll 1
        for (int t = 2; t < nt; t += 2) {
            const bool last = (t == nt - 2);
            const int tt = __builtin_amdgcn_readfirstlane(t);
            const unsigned a1 = cA + (unsigned)(tt + 1) * kstep;
            const unsigned a2 = last ? nA : cA + (unsigned)(tt + 2) * kstep, b2 = last ? nB : cB + (unsigned)(tt + 2) * kstep;
            const unsigned a3 = a2 + kstep, b3 = b2 + kstep;
            unsigned s0[2], s1[2];
            if (GATHER && last && has_next) { const u32x4 nx = gather_read(nxt); s0[0] = nx[0]; s0[1] = nx[1]; s1[0] = nx[2]; s1[1] = nx[3]; }
            else { s0[0] = c0[0]; s0[1] = c0[1]; s1[0] = c1[0]; s1[1] = c1[1]; }
            PG8_LDB(B0, 0, 0); PG8_LDB(B1, 0, 1); PG8_SCHED; PG8_LDA(At, 0, 0); PG8_STAGE(PG8_SA(1, 1), baseA, a1 + hstepA, c1);
            PG8_WAIT_V(8); PG8_WAIT_L(0); PG8_BAR; PG8_MMA(0, 0, At, B0); PG8_MMA(0, 1, At, B1); PG8_BAR; PG8_SCHED;
            PG8_LDA(At, 0, 1); PG8_STAGE(PG8_SB(0, 0), baseB, b2, voffB); PG8_STAGE(PG8_SB(0, 1), baseB, b2 + hstep, voffB); PG8_STAGE(PG8_SA(0, 0), baseA, a2, s0);
            PG8_WAIT_V(8); PG8_WAIT_L(0); PG8_BAR; PG8_MMA(1, 0, At, B0); PG8_MMA(1, 1, At, B1); PG8_BAR; PG8_SCHED;
            PG8_LDB(B0, 1, 0); PG8_LDB(B1, 1, 1); PG8_SCHED; PG8_LDA(At, 1, 0); PG8_STAGE(PG8_SA(0, 1), baseA, a2 + hstepA, s1);
            PG8_WAIT_V(8); PG8_WAIT_L(0); PG8_BAR; PG8_MMA(0, 0, At, B0); PG8_MMA(0, 1, At, B1); PG8_BAR; PG8_SCHED;
            PG8_LDA(At, 1, 1); PG8_STAGE(PG8_SB(1, 0), baseB, b3, voffB); PG8_STAGE(PG8_SB(1, 1), baseB, b3 + hstep, voffB); PG8_STAGE(PG8_SA(1, 0), baseA, a3, s0);
            PG8_WAIT_V(8); PG8_WAIT_L(0); PG8_BAR; PG8_MMA(1, 0, At, B0); PG8_MMA(1, 1, At, B1); PG8_BAR; PG8_SCHED;
        }
        asm volatile("s_nop 15\n\ts_nop 7" ::: "memory");
        if (wr == 0) PG8_BAR;
        if (Epi::HAS_PRE) { E.stash(pre, scr, tid); PG8_WAIT_L(0); PG8_BAR; }
        { int tz = tid; asm volatile("" : "+v"(tz));
          const int lz = tz & 63, wz = tz >> 6; E(acc, cur, wz >> 2, wz & 3, lz & 15, lz >> 4, scr); }
        if (!has_next) break;
        cur = nxt; cA = nA; cB = nB; ++ui;
        if (GATHER) { const u32x4 nx = gather_read(cur); c0[0] = nx[0]; c0[1] = nx[1]; c1[0] = nx[2]; c1[1] = nx[3]; }
        if (wr == 1) PG8_BAR;
    }
    PG8_WAIT_V(0);
    PG8_BAR;
#undef PG8_SA
#undef PG8_SB
#undef PG8_STAGE
#undef PG8_LDA
#undef PG8_LDB
#undef PG8_MMA
#undef PG8_MMAZ
#undef PG8_WAIT_V
#undef PG8_WAIT_VN
#undef PG8_WAIT_L
#undef PG8_BAR
#undef PG8_SCHED
}
}

constexpr int NWAVES = 8;
constexpr int BATCH = 32, SEQ = 2048, D = 1024, DEPTH = 2;
constexpr int M = BATCH * SEQ;
constexpr int NPROJ = 3344, NPROJ_PAD = 3584;
constexpr int NEXP = 32, TOPK = 4, DFF = 1024;
constexpr int CAP = M;
constexpr float LN_EPS = 1e-5f, RMS_EPS = 1e-6f;
constexpr float ALPHA = 1.4142135623730951f;
constexpr int C_GQ = 0, C_GK = 256, C_GV = 512, C_GLG = 1024, C_GOG = 1280, C_HQ = 1792, C_HF = 2048, C_HI = 2304, C_HOG = 2560, C_CB = 2816, C_CC = 3072, C_CH = 3328;
constexpr int SRC_GLR = 1024, GLR_RANK = 16;

constexpr size_t MiB = 1u << 20;
constexpr size_t WS_CTL = 0, CTL_ZERO_BYTES = 1 * MiB;
constexpr size_t W_IN_B = (size_t)NPROJ_PAD * D * 2, W_OUT_B = (size_t)D * D * 2, W_GU_B = (size_t)NEXP * 2048 * D * 2, W_DN_B = (size_t)NEXP * D * DFF * 2;
constexpr size_t W_LAYER_B = W_IN_B + W_OUT_B + W_GU_B + W_DN_B;
constexpr size_t WS_W = 2 * MiB;
constexpr size_t WS_HB = 404 * MiB;
constexpr size_t WS_R1 = 532 * MiB;
constexpr size_t WS_MIX = WS_R1, WS_PROJ = WS_R1 + 128 * MiB, WS_Y = WS_PROJ + 448 * MiB, WS_ACT = WS_PROJ;
constexpr size_t ACT_ROWS = (size_t)M * 4 + NEXP * 256;
static_assert(ACT_ROWS * 1024 <= 576 * MiB, "fp8 activations [ACT_ROWS][1024] fit the proj|Y overlay");
constexpr size_t WS_Y4 = 1236 * MiB;
constexpr size_t WS_SLOT = 1748 * MiB;
constexpr size_t WS_END = 1772 * MiB;
static_assert((size_t)(M * 4 + NEXP * 256) * 1024 * 2 <= 576 * MiB, "act fits the proj|Y region");
constexpr int CW_BAR = 4096;
constexpr int CW_CNT = 16384;
constexpr int CW_CMAX_IN = 65536;
constexpr int CW_CMAX_GU = 65536 + 8192;
static_assert((CW_CMAX_GU + DEPTH * NEXP * 2048) * 4 <= (int)CTL_ZERO_BYTES, "CTL words inside the memset region");
constexpr int CW_CMAX_DN = 262144;
static_assert((size_t)(CW_CMAX_DN + DEPTH * NEXP * 1024) * 4 <= 2 * MiB, "W_down column maxima fit below the weight copies");
constexpr size_t WS_HS = WS_HB + 64 * MiB;

constexpr int RING_BYTES = 131072;
constexpr int MISC_OFF = RING_BYTES;
constexpr int ULIST_OFF = RING_BYTES + 256;
constexpr int TOK_OFF = RING_BYTES + 256 + 2048;
constexpr int LDS_BYTES = 147456;
static_assert(TOK_OFF + 3 * 4096 + 256 + 1024 <= LDS_BYTES, "LDS map");

typedef unsigned short bf16;
typedef unsigned v4u __attribute__((ext_vector_type(4)));
typedef unsigned v2u __attribute__((ext_vector_type(2)));
typedef float f32x4 __attribute__((ext_vector_type(4)));
typedef GAS unsigned gu32;
#define RLX_AGENT __ATOMIC_RELAXED, __HIP_MEMORY_SCOPE_AGENT
#define LDS_WAIT() asm volatile("s_waitcnt lgkmcnt(0)" ::: "memory")
typedef float f32x2_t __attribute__((ext_vector_type(2)));
typedef __bf16 bf16x2_t __attribute__((ext_vector_type(2)));
__device__ __forceinline__ unsigned pk2(float lo, float hi) { const f32x2_t v = {lo, hi}; const bf16x2_t b = __builtin_convertvector(v, bf16x2_t); return __builtin_bit_cast(unsigned, b); }
__device__ __forceinline__ unsigned f2bf(float f) { return pk2(f, f) & 0xffffu; }
using pg8::pack_i8x4;
__device__ __forceinline__ float bf2f(unsigned short b) { return __builtin_bit_cast(float, ((unsigned)b) << 16); }
__device__ __forceinline__ float bflo(unsigned w) { return __builtin_bit_cast(float, w << 16); }
__device__ __forceinline__ float bfhi(unsigned w) { return __builtin_bit_cast(float, w & 0xffff0000u); }

#define XB_TMO      128
#define XB_XCNT(j)  (256  + 64 * (j))
#define XB_XSUB(j)  (1280 + 64 * (j))
#define XB_XGEN(j)  (2304 + 64 * (j))
#define XB_TOP      3328
#define XB_TOPGEN   3392
#define XCD_BAR_WORDS 3456
#define XB_SPIN_CAP (1u << 18)
__device__ __forceinline__ unsigned xb_ld(unsigned* p)              { return __hip_atomic_load(p, __ATOMIC_RELAXED, __HIP_MEMORY_SCOPE_AGENT); }
__device__ __forceinline__ unsigned xb_add(unsigned* p, unsigned v) { return __hip_atomic_fetch_add(p, v, __ATOMIC_RELAXED, __HIP_MEMORY_SCOPE_AGENT); }
__device__ __forceinline__ unsigned xb_xcc_id() { return (unsigned)__builtin_amdgcn_s_getreg((3 << 11) | 20) & 0xFu; }
#define XB_SPIN(cond, bar) do { unsigned _sp = 0; while (cond) { __builtin_amdgcn_s_sleep(1); \
    if ((++_sp & 255u) == 0u) { if (xb_ld(&(bar)[XB_TMO])) break; if (_sp > XB_SPIN_CAP) { atomicAdd(&(bar)[XB_TMO], 1u); break; } } } } while (0)
struct XcdBarrier { unsigned* bar; unsigned x; volatile LAS unsigned* st; };
__device__ __forceinline__ XcdBarrier xcd_barrier_post(unsigned* bar, volatile LAS unsigned* st) {
    XcdBarrier b; b.bar = bar; b.x = xb_xcc_id(); b.st = st;
    if (threadIdx.x == 0) (void)xb_add(&bar[XB_XCNT(b.x)], 1u);
    return b;
}
__device__ __forceinline__ void xcd_barrier_complete(unsigned* bar, unsigned x, unsigned& nloc, unsigned& nx) {
    const unsigned G = gridDim.x * gridDim.y * gridDim.z;
    unsigned sum, cnt, mine, sp = 0u;
    for (;;) {
        sum = 0u; cnt = 0u; mine = 0u;
#pragma unroll
        for (unsigned j = 0; j < 16; ++j) { const unsigned c = xb_ld(&bar[XB_XCNT(j)]); sum += c; cnt += (c > 0u) ? 1u : 0u; mine = (j == x) ? c : mine; }
        if (sum == G) break;
        __builtin_amdgcn_s_sleep(1);
        if ((++sp & 255u) == 0u) { if (xb_ld(&bar[XB_TMO])) break; if (sp > XB_SPIN_CAP) { atomicAdd(&bar[XB_TMO], 1u); break; } }
    }
    nloc = mine > 0u ? mine : 1u; nx = cnt > 0u ? cnt : 1u;
}
__device__ __forceinline__ void xcd_barrier(const XcdBarrier& b, bool leader) {
    asm volatile("s_waitcnt vmcnt(0)" ::: "memory");
    __syncthreads();
    if (leader) {
        unsigned* bar = b.bar;
        __builtin_amdgcn_s_waitcnt(0);
        unsigned nloc = b.st[0], nx = b.st[1];
        if (nloc == 0u) { xcd_barrier_complete(bar, b.x, nloc, nx); b.st[0] = nloc; b.st[1] = nx; }
        const unsigned old = xb_add(&bar[XB_XSUB(b.x)], 1u);
        const unsigned gen = old / nloc;
        if (old + 1u == (gen + 1u) * nloc) {
            __builtin_amdgcn_fence(__ATOMIC_RELEASE, "agent");
            asm volatile("s_waitcnt vmcnt(0)" ::: "memory");
            const unsigned og = xb_add(&bar[XB_TOP], 1u);
            const unsigned tg = og / nx;
            if (og + 1u == (tg + 1u) * nx) xb_add(&bar[XB_TOPGEN], 1u);
            else XB_SPIN(xb_ld(&bar[XB_TOPGEN]) == tg, bar);
            __builtin_amdgcn_fence(__ATOMIC_ACQUIRE, "agent");
            xb_add(&bar[XB_XGEN(b.x)], 1u);
            asm volatile("s_waitcnt vmcnt(0)" ::: "memory");
        } else {
            XB_SPIN(xb_ld(&bar[XB_XGEN(b.x)]) == gen, bar);
            __builtin_amdgcn_fence(__ATOMIC_ACQUIRE, "agent");
            asm volatile("s_waitcnt vmcnt(0)" ::: "memory");
        }
    }
    __syncthreads();
}

struct Frame {
    LAS unsigned char* lds;
    volatile LAS unsigned* MISC;
    gu32* ctl;
    int tid, lane, wave, vcu, G;
    const __attribute__((address_space(4))) unsigned char* ka;
    float* H;
    unsigned char* ws;
};
__device__ __forceinline__ const GAS float* inp(const Frame& F, int i) { return (const GAS float*)*(const float* const __attribute__((address_space(4)))*)(F.ka + 8 * i); }
__device__ __forceinline__ bf16* w_in_t(Frame& F, int l)  { return (bf16*)(F.ws + WS_W + (size_t)l * W_LAYER_B); }
__device__ __forceinline__ bf16* w_out_t(Frame& F, int l) { return (bf16*)(F.ws + WS_W + (size_t)l * W_LAYER_B + W_IN_B); }
__device__ __forceinline__ bf16* w_gu_t(Frame& F, int l)  { return (bf16*)(F.ws + WS_W + (size_t)l * W_LAYER_B + W_IN_B + W_OUT_B); }
__device__ __forceinline__ bf16* w_dn_t(Frame& F, int l)  { return (bf16*)(F.ws + WS_W + (size_t)l * W_LAYER_B + W_IN_B + W_OUT_B + W_GU_B); }

__device__ __forceinline__ void lds_barrier() { asm volatile("s_waitcnt lgkmcnt(0)" ::: "memory"); __builtin_amdgcn_s_barrier(); asm volatile("" ::: "memory"); }
template <int CTRL, int RM> __device__ __forceinline__ float dpp_mv(float v) { return __builtin_bit_cast(float, __builtin_amdgcn_update_dpp(__builtin_bit_cast(int, v), __builtin_bit_cast(int, v), CTRL, RM, 0xf, false)); }
__device__ __forceinline__ float wave_sum(float v) {
    v += dpp_mv<0xb1, 0xf>(v); v += dpp_mv<0x4e, 0xf>(v); v += dpp_mv<0x124, 0xf>(v); v += dpp_mv<0x128, 0xf>(v); v += dpp_mv<0x142, 0xa>(v); v += dpp_mv<0x143, 0xc>(v);
    return __builtin_bit_cast(float, __builtin_amdgcn_readlane(__builtin_bit_cast(int, v), 63));
}
__device__ __forceinline__ float wave_max(float v) {
    v = fmaxf(v, dpp_mv<0xb1, 0xf>(v)); v = fmaxf(v, dpp_mv<0x4e, 0xf>(v)); v = fmaxf(v, dpp_mv<0x124, 0xf>(v)); v = fmaxf(v, dpp_mv<0x128, 0xf>(v)); v = fmaxf(v, dpp_mv<0x142, 0xa>(v)); v = fmaxf(v, dpp_mv<0x143, 0xc>(v));
    return __builtin_bit_cast(float, __builtin_amdgcn_readlane(__builtin_bit_cast(int, v), 63));
}
__device__ __forceinline__ float xmax16(float v) { const unsigned u = __builtin_bit_cast(unsigned, v); auto r = __builtin_amdgcn_permlane16_swap(u, u, false, false); return fmaxf(__builtin_bit_cast(float, (unsigned)r[0]), __builtin_bit_cast(float, (unsigned)r[1])); }

template <int MODE>
__device__ __forceinline__ void p0_transpose_item(const GAS float* W, int K, int N, bf16* WT, LAS float* scr, int item, int lane) {
    const int nblk = (N + 31) / 32, kb = item / nblk, nb = item % nblk, k0 = 64 * kb, n0 = 32 * nb;
    const bool nok = (n0 + (lane & 31)) < N;
#pragma unroll 8
    for (int i = 0; i < 32; ++i) { const int kk = 2 * i + (lane >> 5); scr[kk * 33 + (lane & 31)] = nok ? W[(size_t)(k0 + kk) * N + n0 + (lane & 31)] : 0.f; }
    LDS_WAIT(); asm volatile("" ::: "memory");
    const int c = lane & 7;
#pragma unroll
    for (int j = 0; j < 4; ++j) { const int n = (lane >> 3) + 8 * j; const LAS float* s = scr + (8 * c) * 33 + n;
        v4u o; o.x = pk2(s[0 * 33], s[1 * 33]); o.y = pk2(s[2 * 33], s[3 * 33]); o.z = pk2(s[4 * 33], s[5 * 33]); o.w = pk2(s[6 * 33], s[7 * 33]);
        const int ns = n0 + n;
        int nd = ns;
        if (MODE == 1) { const int half = ns >> 10, cc = ns & 1023; nd = (cc >> 7) * 256 + half * 128 + (cc & 127); }
        if (ns < N) *(GAS v4u*)(WT + (size_t)nd * K + k0 + 8 * c) = o; }
    LDS_WAIT(); asm volatile("" ::: "memory");
}
__device__ __forceinline__ void ln_row(f32x4 (&v)[4], const GAS float* g, const GAS float* b, int lane) {
    float s = 0.f;
#pragma unroll
    for (int j = 0; j < 4; ++j) s += (v[j].x + v[j].y) + (v[j].z + v[j].w);
    const float mean = wave_sum(s) * (1.f / D); float s2 = 0.f;
#pragma unroll
    for (int j = 0; j < 4; ++j) { v[j] = v[j] - mean; s2 += (v[j].x * v[j].x + v[j].y * v[j].y) + (v[j].z * v[j].z + v[j].w * v[j].w); }
    const float rstd = 1.f / sqrtf(wave_sum(s2) * (1.f / D) + LN_EPS);
#pragma unroll
    for (int j = 0; j < 4; ++j) { const f32x4 gg = *(const GAS f32x4*)(g + 4 * lane + 256 * j), bb = *(const GAS f32x4*)(b + 4 * lane + 256 * j); v[j] = v[j] * rstd * gg + bb; }
}
__device__ __forceinline__ float store_row_q(const f32x4 (&v)[4], GAS signed char* qrow, GAS float* hsm, int lane) {
    float mx = 0.f;
#pragma unroll
    for (int j = 0; j < 4; ++j) mx = fmaxf(fmaxf(mx, fmaxf(fabsf(v[j].x), fabsf(v[j].y))), fmaxf(fabsf(v[j].z), fabsf(v[j].w)));
    mx = wave_max(mx); const float inv = mx > 0.f ? 127.0f / mx : 0.f;
#pragma unroll
    for (int j = 0; j < 4; ++j) *(GAS unsigned*)(qrow + 4 * lane + 256 * j) = pack_i8x4(v[j].x * inv, v[j].y * inv, v[j].z * inv, v[j].w * inv);
    if (lane == 0) *hsm = mx * (1.0f / 127.0f);
    return mx * (1.0f / 127.0f);
}
__device__ __forceinline__ void wave_sum2(float& x, float& y) {
    x += dpp_mv<0xb1, 0xf>(x); y += dpp_mv<0xb1, 0xf>(y); x += dpp_mv<0x4e, 0xf>(x); y += dpp_mv<0x4e, 0xf>(y); x += dpp_mv<0x124, 0xf>(x); y += dpp_mv<0x124, 0xf>(y);
    x += dpp_mv<0x128, 0xf>(x); y += dpp_mv<0x128, 0xf>(y); x += dpp_mv<0x142, 0xa>(x); y += dpp_mv<0x142, 0xa>(y); x += dpp_mv<0x143, 0xc>(x); y += dpp_mv<0x143, 0xc>(y);
    x = __builtin_bit_cast(float, __builtin_amdgcn_readlane(__builtin_bit_cast(int, x), 63)); y = __builtin_bit_cast(float, __builtin_amdgcn_readlane(__builtin_bit_cast(int, y), 63));
}
__device__ __forceinline__ void wave_max2(float& x, float& y) {
    x = fmaxf(x, dpp_mv<0xb1, 0xf>(x)); y = fmaxf(y, dpp_mv<0xb1, 0xf>(y)); x = fmaxf(x, dpp_mv<0x4e, 0xf>(x)); y = fmaxf(y, dpp_mv<0x4e, 0xf>(y)); x = fmaxf(x, dpp_mv<0x124, 0xf>(x)); y = fmaxf(y, dpp_mv<0x124, 0xf>(y));
    x = fmaxf(x, dpp_mv<0x128, 0xf>(x)); y = fmaxf(y, dpp_mv<0x128, 0xf>(y)); x = fmaxf(x, dpp_mv<0x142, 0xa>(x)); y = fmaxf(y, dpp_mv<0x142, 0xa>(y)); x = fmaxf(x, dpp_mv<0x143, 0xc>(x)); y = fmaxf(y, dpp_mv<0x143, 0xc>(y));
    x = __builtin_bit_cast(float, __builtin_amdgcn_readlane(__builtin_bit_cast(int, x), 63)); y = __builtin_bit_cast(float, __builtin_amdgcn_readlane(__builtin_bit_cast(int, y), 63));
}
__device__ __forceinline__ void ln_row2(f32x4 (&a)[4], f32x4 (&c)[4], const GAS float* g, const GAS float* b, int lane) {
    float sa = 0.f, sc = 0.f;
#pragma unroll
    for (int j = 0; j < 4; ++j) { sa += (a[j].x + a[j].y) + (a[j].z + a[j].w); sc += (c[j].x + c[j].y) + (c[j].z + c[j].w); }
    wave_sum2(sa, sc); const float ma = sa * (1.f / D), mc = sc * (1.f / D); float qa = 0.f, qc = 0.f;
#pragma unroll
    for (int j = 0; j < 4; ++j) { a[j] = a[j] - ma; c[j] = c[j] - mc; qa += (a[j].x * a[j].x + a[j].y * a[j].y) + (a[j].z * a[j].z + a[j].w * a[j].w); qc += (c[j].x * c[j].x + c[j].y * c[j].y) + (c[j].z * c[j].z + c[j].w * c[j].w); }
    wave_sum2(qa, qc); const float ra = 1.f / sqrtf(qa * (1.f / D) + LN_EPS), rc = 1.f / sqrtf(qc * (1.f / D) + LN_EPS);
#pragma unroll
    for (int j = 0; j < 4; ++j) { const f32x4 gg = *(const GAS f32x4*)(g + 4 * lane + 256 * j), bb = *(const GAS f32x4*)(b + 4 * lane + 256 * j); a[j] = a[j] * ra * gg + bb; c[j] = c[j] * rc * gg + bb; }
}
__device__ __forceinline__ void store_row_q2(const f32x4 (&a)[4], const f32x4 (&c)[4], GAS signed char* qa, GAS signed char* qc, GAS float* hsa, GAS float* hsc, int lane, float& sca, float& scc) {
    float xa = 0.f, xc = 0.f;
#pragma unroll
    for (int j = 0; j < 4; ++j) { xa = fmaxf(fmaxf(xa, fmaxf(fabsf(a[j].x), fabsf(a[j].y))), fmaxf(fabsf(a[j].z), fabsf(a[j].w))); xc = fmaxf(fmaxf(xc, fmaxf(fabsf(c[j].x), fabsf(c[j].y))), fmaxf(fabsf(c[j].z), fabsf(c[j].w))); }
    wave_max2(xa, xc); const float ia = xa > 0.f ? 127.0f / xa : 0.f, ic = xc > 0.f ? 127.0f / xc : 0.f;
#pragma unroll
    for (int j = 0; j < 4; ++j) { *(GAS unsigned*)(qa + 4 * lane + 256 * j) = pack_i8x4(a[j].x * ia, a[j].y * ia, a[j].z * ia, a[j].w * ia); *(GAS unsigned*)(qc + 4 * lane + 256 * j) = pack_i8x4(c[j].x * ic, c[j].y * ic, c[j].z * ic, c[j].w * ic); }
    sca = xa * (1.0f / 127.0f); scc = xc * (1.0f / 127.0f);
    if (lane == 0) { *hsa = sca; *hsc = scc; }
}
__device__ __forceinline__ void load_t(f32x4 (&v)[4], const GAS bf16* hr, const GAS bf16* mr, int lane) {
#pragma unroll
    for (int j = 0; j < 4; ++j) { const v2u h = *(const GAS v2u*)(hr + 4 * lane + 256 * j); const v2u w = *(const GAS v2u*)(mr + 4 * lane + 256 * j);
        v[j].x = bflo(h.x) * ALPHA + bflo(w.x); v[j].y = bfhi(h.x) * ALPHA + bfhi(w.x); v[j].z = bflo(h.y) * ALPHA + bflo(w.y); v[j].w = bfhi(h.y) * ALPHA + bfhi(w.y); }
}
__device__ __forceinline__ void load_raw(v2u (&hr)[4], v2u (&mr)[4], const GAS bf16* hp, const GAS bf16* mp, int lane) {
#pragma unroll
    for (int j = 0; j < 4; ++j) { hr[j] = *(const GAS v2u*)(hp + 4 * lane + 256 * j); mr[j] = *(const GAS v2u*)(mp + 4 * lane + 256 * j); }
}
__device__ __forceinline__ void load_raw_q(v2u (&hr)[4], v2u (&mr)[4], const GAS signed char* hqp, const GAS float* hsp, const GAS bf16* mp, int lane) {
#pragma unroll
    for (int j = 0; j < 4; ++j) { hr[j].x = *(const GAS unsigned*)(hqp + 4 * lane + 256 * j); hr[j].y = 0u; mr[j] = *(const GAS v2u*)(mp + 4 * lane + 256 * j); }
    hr[0].y = __float_as_uint(*hsp);
}
__device__ __forceinline__ void cvt_t_q(f32x4 (&v)[4], const v2u (&hr)[4], const v2u (&mr)[4]) {
    const float sa = __uint_as_float(hr[0].y) * ALPHA;
#pragma unroll
    for (int j = 0; j < 4; ++j) { const int w = (int)hr[j].x;
        v[j].x = (float)((w << 24) >> 24) * sa + bflo(mr[j].x); v[j].y = (float)((w << 16) >> 24) * sa + bfhi(mr[j].x); v[j].z = (float)((w << 8) >> 24) * sa + bflo(mr[j].y); v[j].w = (float)(w >> 24) * sa + bfhi(mr[j].y); }
}
__device__ __forceinline__ void cvt_t(f32x4 (&v)[4], const v2u (&hr)[4], const v2u (&mr)[4]) {
#pragma unroll
    for (int j = 0; j < 4; ++j) { v[j].x = bflo(hr[j].x) * ALPHA + bflo(mr[j].x); v[j].y = bfhi(hr[j].x) * ALPHA + bfhi(mr[j].x); v[j].z = bflo(hr[j].y) * ALPHA + bflo(mr[j].y); v[j].w = bfhi(hr[j].y) * ALPHA + bfhi(mr[j].y); }
}
__device__ __forceinline__ void store_row_b(const f32x4 (&v)[4], GAS bf16* orow, int lane) {
#pragma unroll
    for (int j = 0; j < 4; ++j) { v2u w; w.x = pk2(v[j].x, v[j].y); w.y = pk2(v[j].z, v[j].w); *(GAS v2u*)(orow + 4 * lane + 256 * j) = w; }
}
__device__ __forceinline__ void store_row_f(const f32x4 (&v)[4], float* orow, int lane) {
#pragma unroll
    for (int j = 0; j < 4; ++j) *(GAS f32x4*)(orow + 4 * lane + 256 * j) = v[j];
}
struct PanelSrc { const GAS float* W; const GAS float* W2; int N; signed char* WT; gu32* cmax; int p; int mode; int fp8; };
__device__ __forceinline__ PanelSrc p0_panel_src(Frame& F, int it) {
    constexpr int P_IN = (NPROJ + 31) / 32 + 8, P_GU = 2048 / 32, P_DN = D / 32, PAN_LAYER = P_IN + NEXP * P_GU + NEXP * P_DN;
    const int l = it / PAN_LAYER; int r = it % PAN_LAYER; PanelSrc s; s.W2 = inp(F, 4) + (size_t)l * GLR_RANK * 256;
    if (r < P_IN) { s.W = inp(F, 3) + (size_t)l * D * NPROJ; s.N = NPROJ; s.WT = (signed char*)w_in_t(F, l); s.cmax = F.ctl + CW_CMAX_IN + l * NPROJ_PAD; s.fp8 = 0;
        if (r < P_IN - 8) { s.p = r; s.mode = 2; } else { s.p = r - (P_IN - 8); s.mode = 3; } }
    else if (r < P_IN + NEXP * P_GU) { r -= P_IN; const int e = r / P_GU; s.W = inp(F, 15) + ((size_t)l * NEXP + e) * D * 2048; s.N = 2048; s.WT = (signed char*)w_gu_t(F, l) + (size_t)e * 2048 * D; s.cmax = F.ctl + CW_CMAX_GU + (l * NEXP + e) * 2048; s.p = r % P_GU; s.mode = 1; s.fp8 = 0; }
    else { r -= P_IN + NEXP * P_GU; const int e = r / P_DN; s.W = inp(F, 17) + ((size_t)l * NEXP + e) * DFF * D; s.N = D; s.WT = (signed char*)w_dn_t(F, l) + (size_t)e * D * DFF; s.cmax = F.ctl + CW_CMAX_DN + (l * NEXP + e) * D; s.p = r % P_DN; s.mode = 0; s.fp8 = 1; }
    return s;
}
__device__ __forceinline__ void p0_panel_load(Frame& F, const PanelSrc& s, float (&rg)[64]) {
    const int lane = F.lane, wave = F.wave, n0 = 32 * s.p; const bool nok = (n0 + (lane & 31)) < s.N;
    if (s.mode == 3) {
        float wg[GLR_RANK];
#pragma unroll
        for (int r = 0; r < GLR_RANK; ++r) wg[r] = s.W2[r * 256 + n0 + (lane & 31)];
#pragma unroll
        for (int i = 0; i < 64; ++i) { const int k = 2 * (8 * i + wave) + (lane >> 5); const GAS f32x4* zr = (const GAS f32x4*)(s.W + (size_t)k * s.N + SRC_GLR); float a = 0.f;
#pragma unroll
            for (int q = 0; q < 4; ++q) { const f32x4 z = zr[q]; a += z.x * wg[4 * q] + z.y * wg[4 * q + 1] + z.z * wg[4 * q + 2] + z.w * wg[4 * q + 3]; }
            rg[i] = a; }
        return; }
#pragma unroll
    for (int i = 0; i < 64; ++i) { const int k = 2 * (8 * i + wave) + (lane >> 5); rg[i] = nok ? s.W[(size_t)k * s.N + n0 + (lane & 31)] : 0.f; }
}
__device__ __forceinline__ void p0_panels(Frame& F) {
    constexpr int P_IN = (NPROJ + 31) / 32 + 8, P_GU = 2048 / 32, P_DN = D / 32, PAN_LAYER = P_IN + NEXP * P_GU + NEXP * P_DN, NPAN = DEPTH * PAN_LAYER;
    LAS float* pan = (LAS float*)F.lds; LAS float* pmx = (LAS float*)(F.lds + TOK_OFF);
    const int tid = F.tid, lane = F.lane, wave = F.wave;
    int it = F.vcu; if (it >= NPAN) return;
    float rg[64]; PanelSrc cur = p0_panel_src(F, it); p0_panel_load(F, cur, rg);
    for (;;) {
#pragma unroll
        for (int i = 0; i < 64; ++i) { const int k = 2 * (8 * i + wave) + (lane >> 5); pan[k * 32 + (lane & 31)] = rg[i]; }
        lds_barrier();
        const int itn = it + F.G; const bool more = itn < NPAN; PanelSrc nxt = cur; if (more) { nxt = p0_panel_src(F, itn); p0_panel_load(F, nxt, rg); }
        const int n = tid & 31, ks = tid >> 5;
        float mx = 0.f;
#pragma unroll 8
        for (int i = 0; i < 64; ++i) mx = fmaxf(mx, fabsf(pan[(64 * ks + i) * 32 + n]));
        pmx[ks * 32 + n] = mx;
        lds_barrier();
        float cm = 0.f;
#pragma unroll
        for (int q = 0; q < 16; ++q) cm = fmaxf(cm, pmx[q * 32 + n]);
        const float inv = cm > 0.f ? (cur.fp8 ? pg8::WDN_SC : 127.0f) / cm : 0.f;
        const int ns = 32 * cur.p + n; int nd = ns; bool okc = ns < cur.N;
        if (cur.mode == 1) { const int half = ns >> 10, cc = ns & 1023; nd = (cc >> 7) * 256 + half * 128 + (cc & 127); }
        else if (cur.mode == 2) { nd = ns < SRC_GLR ? ns : ns + (C_GOG - SRC_GLR - GLR_RANK); okc = okc && !(ns >= SRC_GLR && ns < SRC_GLR + GLR_RANK); }
        else if (cur.mode == 3) { nd = C_GLG + ns; okc = ns < 256; }
        if (okc) {
            if (ks == 0) cur.cmax[nd] = __float_as_uint(cm);
            GAS v4u* dst = (GAS v4u*)(cur.WT + (size_t)nd * 1024 + 64 * ks);
#pragma unroll 1
            for (int g4 = 0; g4 < 4; ++g4) { unsigned w[4];
#pragma unroll
            for (int gg = 0; gg < 4; ++gg) { const int g = 4 * g4 + gg; const int kb = (64 * ks + 4 * g) * 32 + n;
                const float x0 = pan[kb] * inv, x1 = pan[kb + 32] * inv, x2 = pan[kb + 64] * inv, x3 = pan[kb + 96] * inv;
                if (cur.fp8) { int v = __builtin_amdgcn_cvt_pk_fp8_f32(x0, x1, 0, false); v = __builtin_amdgcn_cvt_pk_fp8_f32(x2, x3, v, true); w[gg] = (unsigned)v; }
                else w[gg] = pack_i8x4(x0, x1, x2, x3); }
            dst[g4] = (v4u){w[0], w[1], w[2], w[3]}; } }
        lds_barrier();
        if (!more) break;
        it = itn; cur = nxt;
    }
    __syncthreads();
}
__device__ __forceinline__ void p0_prologue(Frame& F) {
    p0_panels(F);
    LAS float* scr = (LAS float*)(F.lds + F.wave * 16384);
    const int gw = F.vcu * NWAVES + F.wave, NGW = F.G * NWAVES;
    constexpr int I_OUT = (D / 64) * (D / 32);
    for (int it = gw; it < DEPTH * I_OUT; it += NGW) { const int l = it / I_OUT, r = it % I_OUT; p0_transpose_item<0>(inp(F, 10) + (size_t)l * D * D, D, D, w_out_t(F, l), scr, r, F.lane); }
    GAS signed char* HQ = (GAS signed char*)(F.ws + WS_HB); GAS float* HS = (GAS float*)(F.ws + WS_HS);
    for (int m = gw; m < M; m += NGW) { f32x4 v[4]; const GAS float* xr = inp(F, 0) + (size_t)m * D;
#pragma unroll
        for (int j = 0; j < 4; ++j) v[j] = *(const GAS f32x4*)(xr + 4 * F.lane + 256 * j);
        ln_row(v, inp(F, 1), inp(F, 2), F.lane); store_row_q(v, HQ + (size_t)m * D, HS + m, F.lane); }
}

__device__ __forceinline__ float sigmoidf_(float x) { return __builtin_amdgcn_rcpf(1.0f + __expf(-x)); }
__device__ __forceinline__ float siluf_(float x) { return x * sigmoidf_(x); }
typedef short s16x4 __attribute__((ext_vector_type(4)));
typedef short v4i16_t __attribute__((ext_vector_type(4)));
typedef short bf16x8_t __attribute__((ext_vector_type(8)));
__device__ __forceinline__ s16x4 tr4(const LAS unsigned char* p) { return __builtin_bit_cast(s16x4, __builtin_amdgcn_ds_read_tr16_b64_v4i16((LAS v4i16_t*)p)); }
__device__ __forceinline__ bf16x8_t cat8(s16x4 a, s16x4 b) { return __builtin_shufflevector(a, b, 0, 1, 2, 3, 4, 5, 6, 7); }
constexpr int RAWP = 136;
constexpr int SC_QRAW = 0, SC_KRAW = 8704, SC_ZRAW = TOK_OFF  , SC_VRAW = 24576, SC_QI = 43008, SC_KI = 53248, SC_QS = 63488, SC_KS = 73728, SC_ST = 83968, SC_SEG = 120832, SC_EGL = 122880, SC_GN = 123136, SC_W = 123648, SC_BG = 127744, SC_XS = 128000, SC_XF = 128512;
constexpr int IMGP = 160, STP = 144;
template <int DV, bool GLA>
__device__ __forceinline__ void scan_chunked(Frame& F, int l, int b, int hd) {
    constexpr int NVT = DV / 16, VP = DV * 2 + 32, NOWN = NVT / 4, NVL = DV / 64;
    LAS unsigned char* L = F.lds;
    const bf16* proj = (const bf16*)(F.ws + WS_PROJ); bf16* Y = (bf16*)(F.ws + WS_Y);
    const int qc = GLA ? C_GQ + hd * 64 : C_HQ + hd * 64, kc = GLA ? C_GK + hd * 64 : C_HF + hd * 64, vc = GLA ? C_GV + hd * 128 : C_HI + hd * 64,
              ogc = GLA ? C_GOG + hd * 128 : C_HOG + hd * 64, yc = GLA ? hd * 128 : 512 + hd * 64;
    const int tid = F.tid, lane = F.lane, wave = F.wave;
    const int d = 8 * wave + (lane & 7), seg = lane >> 3;
    const int li = lane & 15, q4 = lane >> 4, lrow = (lane & 15) >> 2, lcol = 4 * (lane & 3);
    const size_t rowbase = (size_t)b * SEQ;
    float lb = 0.f;
    __syncthreads();
    if (GLA) {
        if (tid < 64) *(LAS float*)(L + SC_BG + tid * 4) = inp(F, 5)[l * 256 + hd * 64 + tid];
    } else if (l > 0) { const float r0 = inp(F, 7)[hd * 64 + d], r1 = inp(F, 7)[256 + hd * 64 + d]; lb = 1.0f / (1.0f + __expf(r0 - r1)); }
    const GAS float* gn = GLA ? inp(F, 6) + l * 128 : inp(F, 8) + l * 64;
    __syncthreads();
    if (tid < DV) *(LAS float*)(L + SC_GN + tid * 4) = gn[tid];
    for (int i = tid; i < DV * STP / 16; i += 512) *(LAS v4u*)(L + SC_ST + i * 16) = (v4u){0u, 0u, 0u, 0u};
    v4u rq, rk, rz, rv[NVL];
    auto issue = [&](int c) {
        const size_t r0 = rowbase + (size_t)c * 64;
        { const int row = tid >> 3, ch = tid & 7; const bf16* p = proj + (r0 + row) * NPROJ_PAD; rq = *(const GAS v4u*)(p + qc + 8 * ch); rk = *(const GAS v4u*)(p + kc + 8 * ch); }
        if (GLA) { const int row = tid >> 3, ch = tid & 7; rz = *(const GAS v4u*)(proj + (r0 + row) * NPROJ_PAD + C_GLG + hd * 64 + 8 * ch); }
#pragma unroll
        for (int j = 0; j < NVL; ++j) { const int idx = tid + 512 * j, row = idx / (DV / 8), ch = idx % (DV / 8); rv[j] = *(const GAS v4u*)(proj + (r0 + row) * NPROJ_PAD + vc + 8 * ch); }
    };
    auto commit_qkz = [&]() {
        { const int row = tid >> 3, ch = tid & 7; const int o = row * RAWP + ch * 16;
            *(LAS v2u*)(L + SC_QRAW + o) = (v2u){rq.x, rq.y}; *(LAS v2u*)(L + SC_QRAW + o + 8) = (v2u){rq.z, rq.w};
            *(LAS v2u*)(L + SC_KRAW + o) = (v2u){rk.x, rk.y}; *(LAS v2u*)(L + SC_KRAW + o + 8) = (v2u){rk.z, rk.w};
            if (GLA) { *(LAS v2u*)(L + SC_ZRAW + o) = (v2u){rz.x, rz.y}; *(LAS v2u*)(L + SC_ZRAW + o + 8) = (v2u){rz.z, rz.w}; } }
    };
    auto commit_v = [&]() {
#pragma unroll
        for (int j = 0; j < NVL; ++j) { const int idx = tid + 512 * j, row = idx / (DV / 8), ch = idx % (DV / 8); *(LAS v4u*)(L + SC_VRAW + row * VP + ch * 16) = rv[j]; }
    };
    issue(0); commit_qkz(); commit_v();
    f32x4 S[4];
#pragma unroll
    for (int dt = 0; dt < 4; ++dt) S[dt] = (f32x4){0.f, 0.f, 0.f, 0.f};
    if (tid < 8) *(LAS int*)(L + SC_XF + tid * 4) = 0;
    __syncthreads();
#pragma unroll 1
    for (int c = 0; c < SEQ / 64; ++c) {
        const int t0 = c * 64;
        if (c + 1 < SEQ / 64) issue(c + 1);
        float cs[8], kv[8];
        {
            float run = 0.f; float bg = 0.f;
            if (GLA) bg = *(const LAS float*)(L + SC_BG + d * 4);
#pragma unroll
            for (int e = 0; e < 8; ++e) { const int T = 8 * seg + e; float g;
                if (GLA) { const float lg = bf2f(*(const LAS unsigned short*)(L + SC_ZRAW + T * RAWP + d * 2)) + bg;
                    g = (fminf(lg, 0.f) - __logf(1.0f + __expf(-fabsf(lg)))) * (1.0f / 16.0f);
                    kv[e] = bf2f(*(const LAS unsigned short*)(L + SC_KRAW + T * RAWP + d * 2)); }
                else { const float z = bf2f(*(const LAS unsigned short*)(L + SC_KRAW + T * RAWP + d * 2)); const float f = lb + (1.0f - lb) * sigmoidf_(z); g = __logf(f); kv[e] = 1.0f - f; }
                run += g; cs[e] = run; }
            *(LAS float*)(L + SC_SEG + (seg * 64 + d) * 4) = run;
        }
        LDS_WAIT(); asm volatile("" ::: "memory");
        {
            float pre = 0.f, rd = 0.f, gl = 0.f;
#pragma unroll
            for (int s2 = 0; s2 < 8; ++s2) { const float v = *(const LAS float*)(L + SC_SEG + (s2 * 64 + d) * 4); if (s2 < seg) pre += v; if (s2 < 4) rd += v; gl += v; }
            const float er = __expf(rd), eglr = __expf(gl - rd);
            float qi[8], ki[8], qs[8], ks[8]; unsigned short qr[8];
#pragma unroll
            for (int e = 0; e < 8; ++e) qr[e] = *(const LAS unsigned short*)(L + SC_QRAW + (8 * seg + e) * RAWP + d * 2);
#pragma unroll
            for (int e = 0; e < 8; ++e) { const float gc = pre + cs[e]; const float E1 = __expf(gc - rd), E2 = __expf(rd - gc);
                float qv = bf2f(qr[e]); qv = GLA ? qv * 0.125f : siluf_(qv);
                qi[e] = qv * E1; qs[e] = qi[e] * er; ki[e] = kv[e] * E2; ks[e] = ki[e] * eglr; }
            v4u w;
            w.x = pk2(qi[0], qi[1]); w.y = pk2(qi[2], qi[3]); w.z = pk2(qi[4], qi[5]); w.w = pk2(qi[6], qi[7]); *(LAS v4u*)(L + SC_QI + d * IMGP + seg * 16) = w;
            w.x = pk2(ki[0], ki[1]); w.y = pk2(ki[2], ki[3]); w.z = pk2(ki[4], ki[5]); w.w = pk2(ki[6], ki[7]); *(LAS v4u*)(L + SC_KI + d * IMGP + seg * 16) = w;
            w.x = pk2(qs[0], qs[1]); w.y = pk2(qs[2], qs[3]); w.z = pk2(qs[4], qs[5]); w.w = pk2(qs[6], qs[7]); *(LAS v4u*)(L + SC_QS + d * IMGP + seg * 16) = w;
            w.x = pk2(ks[0], ks[1]); w.y = pk2(ks[2], ks[3]); w.z = pk2(ks[4], ks[5]); w.w = pk2(ks[6], ks[7]); *(LAS v4u*)(L + SC_KS + d * IMGP + seg * 16) = w;
            if (seg == 0) *(LAS float*)(L + SC_EGL + d * 4) = __expf(gl);
        }
        lds_barrier();
        const LAS unsigned char* STc = L + SC_ST + (c & 1) * (DV * STP);
        LAS unsigned char* STn = L + SC_ST + ((c + 1) & 1) * (DV * STP);
        {
            constexpr int NH = NVT / 2;
            const int it = wave & 3, hh = wave >> 2, I0 = 16 * it, V0 = hh * NH; const size_t row_i = rowbase + t0 + I0 + li;
            v2u ogr[NH];
#pragma unroll
            for (int vt = 0; vt < NH; ++vt) ogr[vt] = *(const GAS v2u*)(proj + row_i * NPROJ_PAD + ogc + 16 * (V0 + vt) + 4 * q4);
            f32x4 pt[4]; s16x4 sf[2][2];
#pragma unroll
            for (int jt = 0; jt < 4; ++jt) pt[jt] = (f32x4){0.f, 0.f, 0.f, 0.f};
#pragma unroll
            for (int ks = 0; ks < 2; ++ks) { const int R0 = 32 * ks + 8 * q4 + lrow; s16x4 kf[4][2], qf[2];
#pragma unroll
                for (int jt = 0; jt < 4; ++jt) { kf[jt][0] = tr4(L + SC_KI + R0 * IMGP + (16 * jt + lcol) * 2); kf[jt][1] = tr4(L + SC_KI + (R0 + 4) * IMGP + (16 * jt + lcol) * 2); }
                qf[0] = tr4(L + SC_QI + R0 * IMGP + (I0 + lcol) * 2); qf[1] = tr4(L + SC_QI + (R0 + 4) * IMGP + (I0 + lcol) * 2);
                sf[ks][0] = tr4(L + SC_QS + R0 * IMGP + (I0 + lcol) * 2); sf[ks][1] = tr4(L + SC_QS + (R0 + 4) * IMGP + (I0 + lcol) * 2);
#pragma unroll
                for (int jt = 0; jt < 4; ++jt) pt[jt] = __builtin_amdgcn_mfma_f32_16x16x32_bf16(cat8(kf[jt][0], kf[jt][1]), cat8(qf[0], qf[1]), pt[jt], 0, 0, 0); }
#pragma unroll
            for (int jt = 0; jt < 4; ++jt)
#pragma unroll
                for (int r = 0; r < 4; ++r) pt[jt][r] = (16 * jt + 4 * q4 + r <= I0 + li) ? pt[jt][r] : 0.f;
            bf16x8_t pb[2], qb[2];
#pragma unroll
            for (int s2 = 0; s2 < 2; ++s2) { v4u w; w.x = pk2(pt[2 * s2][0], pt[2 * s2][1]); w.y = pk2(pt[2 * s2][2], pt[2 * s2][3]); w.z = pk2(pt[2 * s2 + 1][0], pt[2 * s2 + 1][1]); w.w = pk2(pt[2 * s2 + 1][2], pt[2 * s2 + 1][3]);
                pb[s2] = __builtin_bit_cast(bf16x8_t, w); qb[s2] = cat8(sf[s2][0], sf[s2][1]); }
            f32x4 o[NH]; float ss = 0.f;
#pragma unroll
            for (int vp = 0; vp < NH; vp += 2) {
                s16x4 vf[2][2][2]; bf16x8_t stf[2][2];
#pragma unroll
                for (int x = 0; x < 2; ++x)
#pragma unroll
                    for (int s2 = 0; s2 < 2; ++s2) { const int R0 = 32 * s2 + 4 * q4 + lrow;
                        vf[x][s2][0] = tr4(L + SC_VRAW + R0 * VP + (16 * (V0 + vp + x) + lcol) * 2); vf[x][s2][1] = tr4(L + SC_VRAW + (R0 + 16) * VP + (16 * (V0 + vp + x) + lcol) * 2);
                        stf[x][s2] = *(const LAS bf16x8_t*)(STc + (16 * (V0 + vp + x) + li) * STP + (32 * s2 + 8 * q4) * 2); }
#pragma unroll
                for (int x = 0; x < 2; ++x) { f32x4 acc = (f32x4){0.f, 0.f, 0.f, 0.f};
#pragma unroll
                    for (int s2 = 0; s2 < 2; ++s2) acc = __builtin_amdgcn_mfma_f32_16x16x32_bf16(cat8(vf[x][s2][0], vf[x][s2][1]), pb[s2], acc, 0, 0, 0);
#pragma unroll
                    for (int s2 = 0; s2 < 2; ++s2) acc = __builtin_amdgcn_mfma_f32_16x16x32_bf16(stf[x][s2], qb[s2], acc, 0, 0, 0);
                    o[vp + x] = acc; ss += (acc[0] * acc[0] + acc[1] * acc[1]) + (acc[2] * acc[2] + acc[3] * acc[3]); } }
            ss += __shfl_xor(ss, 16); ss += __shfl_xor(ss, 32);
            if (q4 == 0) *(LAS float*)(L + SC_XS + (wave * 16 + li) * 4) = ss;
            LDS_WAIT(); asm volatile("" ::: "memory");
            if (lane == 0) *(volatile LAS int*)(L + SC_XF + wave * 4) = c + 1;
            if (wave < NVT) { const int vt = wave;
                bf16x8_t bk[4][2]; float eg[4];
#pragma unroll
                for (int dt = 0; dt < 4; ++dt) { eg[dt] = *(const LAS float*)(L + SC_EGL + (16 * dt + li) * 4);
#pragma unroll
                    for (int s2 = 0; s2 < 2; ++s2) bk[dt][s2] = *(const LAS bf16x8_t*)(L + SC_KS + (16 * dt + li) * IMGP + (32 * s2 + 8 * q4) * 2); }
                s16x4 vg[2][2];
#pragma unroll
                for (int s2 = 0; s2 < 2; ++s2) { const int R0 = 32 * s2 + 8 * q4 + lrow;
                    vg[s2][0] = tr4(L + SC_VRAW + R0 * VP + (16 * vt + lcol) * 2); vg[s2][1] = tr4(L + SC_VRAW + (R0 + 4) * VP + (16 * vt + lcol) * 2); }
#pragma unroll
                for (int dt = 0; dt < 4; ++dt) { f32x4 acc = S[dt] * eg[dt];
#pragma unroll
                    for (int s2 = 0; s2 < 2; ++s2) acc = __builtin_amdgcn_mfma_f32_16x16x32_bf16(cat8(vg[s2][0], vg[s2][1]), bk[dt][s2], acc, 0, 0, 0);
                    S[dt] = acc; }
#pragma unroll
                for (int dt = 0; dt < 4; ++dt)
#pragma unroll
                    for (int r = 0; r < 4; r += 2) { const unsigned w = pk2(S[dt][r], S[dt][r + 1]);
                        *(LAS unsigned short*)(STn + (16 * vt + 4 * q4 + r) * STP + (16 * dt + li) * 2) = (unsigned short)(w & 0xffffu);
                        *(LAS unsigned short*)(STn + (16 * vt + 4 * q4 + r + 1) * STP + (16 * dt + li) * 2) = (unsigned short)(w >> 16); } }
            { const int pw = wave ^ 4; int sp = 0;
                while (*(volatile LAS int*)(L + SC_XF + pw * 4) != c + 1) { __builtin_amdgcn_s_sleep(1); if (++sp > (1 << 20)) break; }
                asm volatile("" ::: "memory");
                ss += *(volatile LAS float*)(L + SC_XS + (pw * 16 + li) * 4); }
            const float rn = __builtin_amdgcn_rsqf(ss * (1.0f / DV) + RMS_EPS);
#pragma unroll
            for (int vp = 0; vp < NH; vp += 2) { v2u w2[2];
#pragma unroll
                for (int x = 0; x < 2; ++x) { const int vt = vp + x; const f32x4 g4 = *(const LAS f32x4*)(L + SC_GN + (16 * (V0 + vt) + 4 * q4) * 4);
                    const float y0 = o[vt][0] * rn * g4[0] * siluf_(bflo(ogr[vt].x)), y1 = o[vt][1] * rn * g4[1] * siluf_(bfhi(ogr[vt].x)),
                                y2 = o[vt][2] * rn * g4[2] * siluf_(bflo(ogr[vt].y)), y3 = o[vt][3] * rn * g4[3] * siluf_(bfhi(ogr[vt].y));
                    w2[x].x = pk2(y0, y1); w2[x].y = pk2(y2, y3); }
                auto r0 = __builtin_amdgcn_permlane16_swap(w2[0].x, w2[1].x, false, false); auto r1 = __builtin_amdgcn_permlane16_swap(w2[0].y, w2[1].y, false, false);
                const int odd = q4 & 1;
                *(GAS v4u*)(Y + row_i * D + yc + 16 * (V0 + vp + odd) + 4 * (q4 - odd)) = (v4u){(unsigned)r0[0], (unsigned)r1[0], (unsigned)r0[1], (unsigned)r1[1]}; }
        }
        if (c + 1 < SEQ / 64) commit_qkz();
        lds_barrier();
        if (c + 1 < SEQ / 64) commit_v();
    }
}
__device__ __forceinline__ void p2_scan(Frame& F, int l) {
    for (int it = F.vcu; it < BATCH * 8; it += F.G) { const int b = it >> 3, u = it & 7;
        if (u < 4) scan_chunked<128, true>(F, l, b, u); else scan_chunked<64, false>(F, l, b, u - 4); }
    const bf16* proj = (const bf16*)(F.ws + WS_PROJ); bf16* Y = (bf16*)(F.ws + WS_Y);
    const GAS float* cw = inp(F, 9) + (size_t)l * 3 * 256;
    const bool even = (F.G == BATCH * 8); const bool isg = (F.vcu & 7) < 4; const int gi = (F.vcu >> 3) * 4 + ((F.vcu & 7) & 3);
    const long NCH = (long)M * 32 / 512, c_lo = even ? (isg ? 0 : CONV_GLA_CHUNKS) : 0, c_hi = even ? (isg ? CONV_GLA_CHUNKS : NCH) : NCH;
    const long cstart = (c_lo + (even ? gi : F.vcu)) * 512 + F.tid, cstride = (even ? 128L : (long)F.G) * 512;
    {
        const int ch = (int)(cstart & 31) * 8; const long cend = c_hi * 512;
        float cwr[3][8];
#pragma unroll
        for (int j = 0; j < 3; ++j)
#pragma unroll
            for (int q = 0; q < 8; ++q) cwr[j][q] = cw[256 * j + ch + q];
        v4u ccn[3], hhn[3], bbn;
        auto ld = [&](long idx) { const int row = (int)(idx >> 5), t = row & (SEQ - 1);
#pragma unroll
            for (int j = 0; j < 3; ++j) { const int dt = 2 - j; const int rr = (t - dt >= 0) ? row - dt : row;
                ccn[j] = *(const GAS v4u*)(proj + (size_t)rr * NPROJ_PAD + C_CC + ch); hhn[j] = *(const GAS v4u*)(proj + (size_t)rr * NPROJ_PAD + C_CH + ch); }
            bbn = *(const GAS v4u*)(proj + (size_t)row * NPROJ_PAD + C_CB + ch); };
        if (cstart < cend) ld(cstart);
#pragma unroll 1
        for (long idx = cstart; idx < cend; idx += cstride) { const int row = (int)(idx >> 5), t = row & (SEQ - 1);
            v4u cc[3], hh[3]; const v4u bb = bbn;
#pragma unroll
            for (int j = 0; j < 3; ++j) { cc[j] = ccn[j]; hh[j] = hhn[j]; }
            if (idx + cstride < cend) ld(idx + cstride);
            float o[8];
#pragma unroll
            for (int q = 0; q < 8; ++q) { float cv = 0.f;
#pragma unroll
                for (int j = 0; j < 3; ++j) { const unsigned cw2 = cc[j][q >> 1], hw2 = hh[j][q >> 1]; const float u = (q & 1) ? bfhi(cw2) * bfhi(hw2) : bflo(cw2) * bflo(hw2); cv += (t - (2 - j) >= 0) ? cwr[j][q] * u : 0.f; }
                const float bq = (q & 1) ? bfhi(bb[q >> 1]) : bflo(bb[q >> 1]); o[q] = bq * cv; }
            v4u w; w.x = pk2(o[0], o[1]); w.y = pk2(o[2], o[3]); w.z = pk2(o[4], o[5]); w.w = pk2(o[6], o[7]);
            *(GAS v4u*)(Y + (size_t)row * D + 768 + ch) = w; }
    }
}

constexpr int R_PITCH = 2064;
constexpr int R_HI = 0, R_LO = 16 * R_PITCH, R_PART = 2 * 16 * R_PITCH;
static_assert(R_PART + 8 * 16 * 32 * 4 <= RING_BYTES, "router LDS map");
__device__ __forceinline__ void p4_ln_router(Frame& F, int l) {
    LAS unsigned char* L = F.lds;
    LAS int* tokE = (LAS int*)(L + TOK_OFF); LAS int* tokP = tokE + 1024; LAS float* tokG = (LAS float*)(tokP + 1024);
    LAS int* lcnt = (LAS int*)(tokG + 1024); LAS int* gbase = lcnt + 32; LAS float* tokS = (LAS float*)(gbase + 32);
    const GAS float* Wr = inp(F, 13) + (size_t)l * D * NEXP; const GAS float* br = inp(F, 14) + l * NEXP;
    const GAS float* lng = inp(F, 11) + l * D; const GAS float* lnb = inp(F, 12) + l * D;
    GAS signed char* HQ = (GAS signed char*)(F.ws + WS_HB); GAS float* HS = (GAS float*)(F.ws + WS_HS);
    GAS int* slot_dst = (GAS int*)(F.ws + WS_SLOT); GAS float* slot_gate = (GAS float*)(F.ws + WS_SLOT + 8 * MiB); GAS float* slot_hs = (GAS float*)(F.ws + WS_SLOT + 16 * MiB);
    GAS bf16* MIX = (GAS bf16*)(F.ws + WS_MIX);
    gu32* gcnt = F.ctl + CW_CNT + l * 64;
    const int tid = F.tid, lane = F.lane, wave = F.wave, li = lane & 15, q4 = lane >> 4;
    bf16x8_t whi[4][2], wlo[4][2];
#pragma unroll
    for (int ks = 0; ks < 4; ++ks)
#pragma unroll
        for (int nt = 0; nt < 2; ++nt) { float w[8], wl[8];
#pragma unroll
            for (int j = 0; j < 8; ++j) { w[j] = Wr[(size_t)(128 * wave + 32 * ks + 8 * q4 + j) * NEXP + 16 * nt + li]; wl[j] = w[j] - bf2f((unsigned short)f2bf(w[j])); }
            v4u a, b; a.x = pk2(w[0], w[1]); a.y = pk2(w[2], w[3]); a.z = pk2(w[4], w[5]); a.w = pk2(w[6], w[7]); b.x = pk2(wl[0], wl[1]); b.y = pk2(wl[2], wl[3]); b.z = pk2(wl[4], wl[5]); b.w = pk2(wl[6], wl[7]);
            whi[ks][nt] = __builtin_bit_cast(bf16x8_t, a); wlo[ks][nt] = __builtin_bit_cast(bf16x8_t, b); }
    __syncthreads();
    for (int tb = F.vcu; tb < M / 256; tb += F.G) {
        if (tid < 32) lcnt[tid] = 0;
        v2u hA[2][4], mA[2][4], hB[2][4], mB[2][4];
#pragma unroll
        for (int r = 0; r < 2; ++r) { const size_t m0 = (size_t)(tb * 256 + 2 * wave + r); load_raw_q(hA[r], mA[r], HQ + m0 * D, HS + m0, MIX + m0 * D, lane);
            load_raw_q(hB[r], mB[r], HQ + (m0 + 16) * D, HS + m0 + 16, MIX + (m0 + 16) * D, lane); }
#pragma unroll 1
        for (int g2 = 0; g2 < 16; g2 += 2) {
#pragma unroll
          for (int par = 0; par < 2; ++par) { const int g = g2 + par;
            f32x4 v[2][4];
#pragma unroll
            for (int r = 0; r < 2; ++r) { if (par == 0) cvt_t_q(v[r], hA[r], mA[r]); else cvt_t_q(v[r], hB[r], mB[r]); }
            if (g + 2 < 16) {
#pragma unroll
                for (int r = 0; r < 2; ++r) { const size_t m0 = (size_t)(tb * 256 + (g + 2) * 16 + 2 * wave + r);
                    if (par == 0) load_raw_q(hA[r], mA[r], HQ + m0 * D, HS + m0, MIX + m0 * D, lane); else load_raw_q(hB[r], mB[r], HQ + m0 * D, HS + m0, MIX + m0 * D, lane); } }
            { const size_t m0 = (size_t)tb * 256 + g * 16 + 2 * wave; float sc0, sc1;
                ln_row2(v[0], v[1], lng, lnb, lane); store_row_q2(v[0], v[1], HQ + m0 * D, HQ + (m0 + 1) * D, HS + m0, HS + m0 + 1, lane, sc0, sc1);
                if (lane == 0) { tokS[g * 16 + 2 * wave] = sc0; tokS[g * 16 + 2 * wave + 1] = sc1; } }
#pragma unroll
            for (int r = 0; r < 2; ++r) { const int trow = 2 * wave + r;
#pragma unroll
                for (int j = 0; j < 4; ++j) { const f32x4 x = v[r][j]; v2u hi; hi.x = pk2(x.x, x.y); hi.y = pk2(x.z, x.w);
                    v2u lo; lo.x = pk2(x.x - bflo(hi.x), x.y - bfhi(hi.x)); lo.y = pk2(x.z - bflo(hi.y), x.w - bfhi(hi.y));
                    *(LAS v2u*)(L + R_HI + trow * R_PITCH + (4 * lane + 256 * j) * 2) = hi; *(LAS v2u*)(L + R_LO + trow * R_PITCH + (4 * lane + 256 * j) * 2) = lo; } }
            lds_barrier();
            f32x4 acc[2] = {(f32x4){0.f, 0.f, 0.f, 0.f}, (f32x4){0.f, 0.f, 0.f, 0.f}}, acb[2] = {(f32x4){0.f, 0.f, 0.f, 0.f}, (f32x4){0.f, 0.f, 0.f, 0.f}}, acc3[2] = {(f32x4){0.f, 0.f, 0.f, 0.f}, (f32x4){0.f, 0.f, 0.f, 0.f}};
            bf16x8_t ah[4], al[4];
#pragma unroll
            for (int ks = 0; ks < 4; ++ks) { ah[ks] = *(const LAS bf16x8_t*)(L + R_HI + li * R_PITCH + (128 * wave + 32 * ks + 8 * q4) * 2); al[ks] = *(const LAS bf16x8_t*)(L + R_LO + li * R_PITCH + (128 * wave + 32 * ks + 8 * q4) * 2); }
#pragma unroll
            for (int ks = 0; ks < 4; ++ks)
#pragma unroll
                for (int nt = 0; nt < 2; ++nt) { acc[nt] = __builtin_amdgcn_mfma_f32_16x16x32_bf16(ah[ks], whi[ks][nt], acc[nt], 0, 0, 0);
                    acb[nt] = __builtin_amdgcn_mfma_f32_16x16x32_bf16(al[ks], whi[ks][nt], acb[nt], 0, 0, 0); acc3[nt] = __builtin_amdgcn_mfma_f32_16x16x32_bf16(ah[ks], wlo[ks][nt], acc3[nt], 0, 0, 0); }
#pragma unroll
            for (int nt = 0; nt < 2; ++nt) acc[nt] = acc[nt] + (acb[nt] + acc3[nt]);
#pragma unroll
            for (int nt = 0; nt < 2; ++nt)
#pragma unroll
                for (int r = 0; r < 4; ++r) *(LAS float*)(L + R_PART + ((wave * 16 + 4 * q4 + r) * 32 + 16 * nt + li) * 4) = acc[nt][r];
            lds_barrier();
            { const int row = tid >> 5, e = tid & 31; float val = br[e]; float pw[8];
#pragma unroll
                for (int w = 0; w < 8; ++w) pw[w] = *(const LAS float*)(L + R_PART + ((w * 16 + row) * 32 + e) * 4);
                val += ((pw[0] + pw[1]) + (pw[2] + pw[3])) + ((pw[4] + pw[5]) + (pw[6] + pw[7]));
                float tv[4]; int te[4];
#pragma unroll
                for (int k = 0; k < 4; ++k) { float mx = val;
                    mx = fmaxf(mx, dpp_mv<0xb1, 0xf>(mx)); mx = fmaxf(mx, dpp_mv<0x4e, 0xf>(mx)); mx = fmaxf(mx, dpp_mv<0x124, 0xf>(mx)); mx = fmaxf(mx, dpp_mv<0x128, 0xf>(mx)); mx = xmax16(mx);
                    const unsigned long long bal = __ballot(val == mx); const unsigned hb32 = (unsigned)(bal >> (lane & 32)); const int es = __builtin_ctz(hb32);
                    tv[k] = mx; te[k] = es; if (e == es) val = -3.0e38f; }
                const float e1 = __expf(tv[1] - tv[0]), e2 = __expf(tv[2] - tv[0]), e3 = __expf(tv[3] - tv[0]); const float inv = __builtin_amdgcn_rcpf(1.0f + e1 + e2 + e3);
                if (e < 4) { const int ek = e == 0 ? te[0] : e == 1 ? te[1] : e == 2 ? te[2] : te[3];
                    const float gk = (e == 0 ? 1.0f : e == 1 ? e1 : e == 2 ? e2 : e3) * inv; const int tl = g * 16 + row;
                    const int lp = __hip_atomic_fetch_add(lcnt + ek, 1, __ATOMIC_RELAXED, __HIP_MEMORY_SCOPE_WORKGROUP);
                    tokE[tl * 4 + e] = ek; tokP[tl * 4 + e] = lp; tokG[tl * 4 + e] = gk; } }
          }
        }
        __syncthreads();
        if (tid < 32) gbase[tid] = (int)__hip_atomic_fetch_add(gcnt + tid, (unsigned)lcnt[tid], RLX_AGENT);
        __syncthreads();
        for (int i = tid; i < 1024; i += 512) { const int e = tokE[i], pos = gbase[e] + tokP[i]; const size_t si = (size_t)e * CAP + pos;
            slot_dst[si] = (tb * 256 + (i >> 2)) * 4 + (i & 3); slot_gate[si] = tokG[i]; slot_hs[si] = tokS[i >> 2]; }
        __syncthreads();
    }
}

__device__ __forceinline__ int build_units(Frame& F, int l, int NT) {
    LAS int* list = (LAS int*)(F.lds + ULIST_OFF);
    gu32* gcnt = F.ctl + CW_CNT + l * 64;
    LAS int* cnts = (LAS int*)(F.lds + TOK_OFF);
    __syncthreads();
    if (F.tid < NEXP) cnts[F.tid] = (int)__hip_atomic_load(gcnt + F.tid, RLX_AGENT);
    __syncthreads();
    int nU = 0;
    {
        int tot = 0; for (int e = 0; e < NEXP; ++e) { const int c = cnts[e]; tot += ((c + 255) >> 8) * NT; }
        nU = (tot > F.vcu) ? (tot - F.vcu + F.G - 1) / F.G : 0; if (nU > 64) nU = 64;
        if (F.tid < nU) { const int q = F.tid * F.G + F.vcu; int base = 0, blk0 = 0, e = 0, c = 0, nb = 0;
            for (e = 0; e < NEXP; ++e) { c = cnts[e]; nb = (c + 255) >> 8; if (q < base + nb * NT) break; base += nb * NT; blk0 += nb; }
            const int lq = q - base, rg = lq / (8 * NT), l2 = lq % (8 * NT), gsz = (nb - 8 * rg) < 8 ? (nb - 8 * rg) : 8, pn = l2 / gsz, rb = 8 * rg + l2 % gsz;
            list[F.tid * 8 + 0] = blk0 + rb; list[F.tid * 8 + 1] = e * NT + pn; list[F.tid * 8 + 2] = e; list[F.tid * 8 + 3] = rb; list[F.tid * 8 + 4] = c; }
    }
    __syncthreads();
    return nU;
}


__device__ __forceinline__ void p7_combine(Frame& F, int l) {
    const int gw = F.vcu * NWAVES + F.wave, NGW = F.G * NWAVES, lane = F.lane;
    const GAS unsigned char* y4 = (const GAS unsigned char*)(F.ws + WS_Y4);
    GAS signed char* HQ = (GAS signed char*)(F.ws + WS_HB); GAS float* HS = (GAS float*)(F.ws + WS_HS);
    const GAS float* g2 = inp(F, 19) + l * D; const GAS float* b2 = inp(F, 20) + l * D;
    const bool lastl = (l == DEPTH - 1);
    for (int m = 4 * gw; m < M; m += 4 * NGW) {
        f32x4 v[4][4]; unsigned hv[4][4]; float hsa[4]; unsigned yv[4][4][4];
#pragma unroll
        for (int r = 0; r < 4; ++r) {
#pragma unroll
            for (int j = 0; j < 4; ++j) hv[r][j] = *(const GAS unsigned*)(HQ + (size_t)(m + r) * D + 4 * lane + 256 * j);
            hsa[r] = HS[m + r] * ALPHA;
#pragma unroll
            for (int k = 0; k < 4; ++k)
#pragma unroll
                for (int j = 0; j < 4; ++j) yv[r][k][j] = *(const GAS unsigned*)(y4 + ((size_t)(m + r) * 4 + k) * D + 4 * lane + 256 * j); }
#pragma unroll
        for (int r = 0; r < 4; ++r) {
#pragma unroll
            for (int j = 0; j < 4; ++j) { const int hw = (int)hv[r][j]; f32x4 a; a.x = (float)((hw << 24) >> 24) * hsa[r]; a.y = (float)((hw << 16) >> 24) * hsa[r]; a.z = (float)((hw << 8) >> 24) * hsa[r]; a.w = (float)(hw >> 24) * hsa[r];
                f32x4 ys = (f32x4){0.f, 0.f, 0.f, 0.f};
#pragma unroll
                for (int k = 0; k < 4; ++k) { const int w = (int)yv[r][k][j]; ys.x += __builtin_amdgcn_cvt_f32_fp8(w, 0); ys.y += __builtin_amdgcn_cvt_f32_fp8(w, 1); ys.z += __builtin_amdgcn_cvt_f32_fp8(w, 2); ys.w += __builtin_amdgcn_cvt_f32_fp8(w, 3); }
                v[r][j] = a + ys * (1.0f / 16.0f); }
            ln_row(v[r], g2, b2, lane);
            if (lastl) store_row_f(v[r], F.H + (size_t)(m + r) * D, lane);
            else store_row_q(v[r], HQ + (size_t)(m + r) * D, HS + m + r, lane); }
    }
}

struct Args { const float* in[21]; float* out; unsigned char* ws; int ph_lo, ph_hi; };
constexpr int N_PHASES = 2 + 7 * DEPTH;
__global__ void __launch_bounds__(NWAVES * 64, 2) fwd_kernel(Args args) {
    extern __shared__ __attribute__((aligned(16))) unsigned char lds[];
    Frame F;
    F.lds = (LAS unsigned char*)lds;
    F.MISC = (volatile LAS unsigned*)(F.lds + MISC_OFF);
    F.tid = threadIdx.x; F.lane = F.tid & 63; F.wave = __builtin_amdgcn_readfirstlane(F.tid >> 6);
    F.G = gridDim.x; { const int bx = blockIdx.x; F.vcu = (F.G % 8 == 0) ? (bx % 8) * (F.G / 8) + bx / 8 : bx; }
    F.ws = args.ws; F.ctl = (gu32*)(args.ws + WS_CTL); F.H = args.out;
    F.ka = (const __attribute__((address_space(4))) unsigned char*)__builtin_amdgcn_kernarg_segment_ptr();
    for (int u = F.tid; u < 64; u += NWAVES * 64) ((LAS unsigned*)(F.lds + MISC_OFF))[u] = 0u;
    __syncthreads();
#if MK_ONE_LAUNCH
    XcdBarrier bar = xcd_barrier_post((unsigned*)(F.ctl + CW_BAR), F.MISC + 8);
#define GRID_BAR() xcd_barrier(bar, F.tid == 0)
#else
#define GRID_BAR() do {} while (0)
#endif
#if MK_ONE_LAUNCH
    constexpr int lo = 0, hi = N_PHASES;
#else
    const int lo = args.ph_lo, hi = args.ph_hi;
#endif
#ifndef PH_MASK
#define PH_MASK 0xff
#endif
#define IN(k) (lo <= (k) && (k) < hi)
#define PHON(j) ((PH_MASK >> (j)) & 1)
#ifndef P7_DRY
#define P7_DRY 0
#endif
#ifndef P4_DRY
#define P4_DRY 0
#endif
#ifndef REP_MASK
#define REP_MASK 0
#endif
#define NREP(j) (((REP_MASK >> (j)) & 1) ? 2 : 1)
#define OPQ(p) do { unsigned _lo = (unsigned)(uintptr_t)(p), _hi = (unsigned)((uintptr_t)(p) >> 32); asm volatile("" : "+v"(_lo), "+v"(_hi)); _lo = __builtin_amdgcn_readfirstlane(_lo); _hi = __builtin_amdgcn_readfirstlane(_hi); \
        (p) = (decltype(p))(((uintptr_t)_hi << 32) | _lo); } while (0)
#define REFRESH() do { OPQ(F.ka); OPQ(F.ws); OPQ(F.H); F.lane = (int)__builtin_amdgcn_mbcnt_hi(~0u, __builtin_amdgcn_mbcnt_lo(~0u, 0u)); F.tid = (F.wave << 6) | F.lane; asm volatile("" : "+v"(F.tid)); F.lane = F.tid & 63; F.ctl = (gu32*)(F.ws + WS_CTL); F.lds = (LAS unsigned char*)lds; } while (0)
    if (PHON(0) && IN(1)) for (int rep = 0; rep < NREP(0); ++rep) { REFRESH(); p0_prologue(F); GRID_BAR(); }
#pragma unroll 1
    for (int l = 0; l < DEPTH; ++l) {
        const int pb = 2 + 7 * l;
        if (PHON(1) && IN(pb + 0)) for (int rep = 0; rep < NREP(1); ++rep) { REFRESH();
            pg8::Gemm g{(const bf16*)(F.ws + WS_HB), w_in_t(F, l), D}; pg8::StaticOrder S; S.init(M, NPROJ_PAD, F.G, (int)blockIdx.x);
            pg8::EpiProj E{(bf16*)(F.ws + WS_PROJ), NPROJ_PAD, (const GAS float*)(F.ws + WS_HS), (const GAS unsigned*)(F.ctl + CW_CMAX_IN + l * NPROJ_PAD)};
            pg8::gemm_phase<pg8::EpiProj, pg8::StaticOrder, false, 1>(F.lds, (LAS unsigned*)(F.lds + TOK_OFF), g, S, E, F.tid);
            GRID_BAR();
        }
        if (PHON(2) && IN(pb + 1)) for (int rep = 0; rep < NREP(2); ++rep) { REFRESH(); p2_scan(F, l); GRID_BAR(); }
        if (PHON(3) && IN(pb + 2)) { REFRESH();
            pg8::Gemm g{(const bf16*)(F.ws + WS_Y), w_out_t(F, l), D}; pg8::StaticOrder S; S.init(M, D, F.G, (int)blockIdx.x);
            pg8::EpiMix E{(bf16*)(F.ws + WS_MIX)};
            pg8::gemm_phase<pg8::EpiMix, pg8::StaticOrder, false, 0>(F.lds, (LAS unsigned*)(F.lds + TOK_OFF), g, S, E, F.tid);
            GRID_BAR();
        }
                if (PHON(4) && IN(pb + 3)) { REFRESH(); p4_ln_router(F, l); GRID_BAR(); }
        if (PHON(5) && IN(pb + 4)) for (int rep = 0; rep < NREP(5); ++rep) { REFRESH();
            const int nU = build_units(F, l, 8);
            pg8::Gemm g{(const bf16*)(F.ws + WS_HB), w_gu_t(F, l), D};
            pg8::ListOrder S{(const LAS int*)(F.lds + ULIST_OFF), nU, (const GAS int*)(F.ws + WS_SLOT), CAP, 1024u};
            pg8::EpiSwiglu E{(unsigned char*)(F.ws + WS_ACT), inp(F, 16) + (size_t)l * NEXP * 2048, (const GAS float*)(F.ws + WS_SLOT + 16 * MiB), (const GAS unsigned*)(F.ctl + CW_CMAX_GU + l * NEXP * 2048), CAP};
            pg8::gemm_phase<pg8::EpiSwiglu, pg8::ListOrder, true, 1>(F.lds, (LAS unsigned*)(F.lds + TOK_OFF), g, S, E, F.tid);
            GRID_BAR();
        }
        if (PHON(6) && IN(pb + 5)) for (int rep = 0; rep < NREP(6); ++rep) { REFRESH();
            const int nU = build_units(F, l, 4);
            pg8::Gemm g{(const bf16*)(F.ws + WS_ACT), w_dn_t(F, l), DFF};
            pg8::ListOrder S{(const LAS int*)(F.lds + ULIST_OFF), nU, (const GAS int*)(F.ws + WS_SLOT), CAP, 1024u};
            pg8::EpiDown E{(bf16*)(F.ws + WS_Y4), M * 4, inp(F, 18) + (size_t)l * NEXP * D, (const GAS int*)(F.ws + WS_SLOT), (const GAS float*)(F.ws + WS_SLOT + 8 * MiB), (const GAS unsigned*)(F.ctl + CW_CMAX_DN + l * NEXP * D), CAP};
            pg8::gemm_phase<pg8::EpiDown, pg8::ListOrder, false, 2>(F.lds, (LAS unsigned*)(F.lds + TOK_OFF), g, S, E, F.tid);
            GRID_BAR();
        }
        if (PHON(7) && IN(pb + 6)) { REFRESH(); p7_combine(F, l); if (l + 1 < DEPTH) GRID_BAR(); }
    }
#undef IN
}

extern "C" void kernel_launch(void* const* d_in, const int* in_sizes, int n_in, void* d_out, int out_size, void* d_ws, size_t ws_size, hipStream_t stream) {
    static int grid = 0;
    if (grid == 0) {
        if (n_in != 21 || in_sizes[0] != M * D || out_size != M * D || ws_size < WS_END) { fprintf(stderr, "kernel_launch: unexpected shapes (n_in %d, in0 %d, out %d, ws %zu)\n", n_in, n_in > 0 ? in_sizes[0] : -1, out_size, ws_size); grid = -1; return; }
        int dev = 0, cus = 0, per_cu = 0;
        if (hipGetDevice(&dev) != hipSuccess || hipDeviceGetAttribute(&cus, hipDeviceAttributeMultiprocessorCount, dev) != hipSuccess) { grid = -1; return; }
        if (hipFuncSetAttribute((const void*)fwd_kernel, hipFuncAttributeMaxDynamicSharedMemorySize, LDS_BYTES) != hipSuccess) { fprintf(stderr, "kernel_launch: hipFuncSetAttribute failed\n"); grid = -1; return; }
        if (hipOccupancyMaxActiveBlocksPerMultiprocessor(&per_cu, (const void*)fwd_kernel, NWAVES * 64, LDS_BYTES) != hipSuccess || per_cu < 1) fprintf(stderr, "kernel_launch: occupancy query says %d\n", per_cu);
        (void)hipGetLastError();
        grid = cus;
    }
    if (grid < 0) return;
    if (hipMemsetAsync((char*)d_ws + WS_CTL, 0, 128 * 1024, stream) != hipSuccess) return;
    Args a{};
    for (int i = 0; i < 21; ++i) a.in[i] = (const float*)d_in[i];
    a.out = (float*)d_out; a.ws = (unsigned char*)d_ws;
#if MK_ONE_LAUNCH
    a.ph_lo = 0; a.ph_hi = N_PHASES;
    hipLaunchKernelGGL(fwd_kernel, dim3(grid), dim3(NWAVES * 64), LDS_BYTES, stream, a);
#else
    for (int p = 0; p < N_PHASES; ++p) { a.ph_lo = p; a.ph_hi = p + 1; hipLaunchKernelGGL(fwd_kernel, dim3(grid), dim3(NWAVES * 64), LDS_BYTES, stream, a); }
#endif
}
```

```cpp
#include <hip/hip_runtime.h>
#include <cstdio>
#include <cstdint>

#ifndef CONV_GLA_CHUNKS
#define CONV_GLA_CHUNKS 768
#endif
#ifndef MK_ONE_LAUNCH
#define MK_ONE_LAUNCH 1
#endif

#define GAS __attribute__((address_space(1)))
#define LAS __attribute__((address_space(3)))
namespace pg8 {
#define PG8_LAS __attribute__((address_space(3)))
typedef unsigned short bf16_t;
typedef short bf16x8 __attribute__((ext_vector_type(8)));
typedef float f32x4 __attribute__((ext_vector_type(4)));
typedef unsigned u32x4 __attribute__((ext_vector_type(4)));
typedef int i32x4 __attribute__((ext_vector_type(4)));
constexpr int BM = 256, BK = 64, HALF = 128, HTB = HALF * BK * 2, STAGE_BYTES = 8 * HTB, NXCD = 8, WGM = 8;

__host__ __device__ __forceinline__ int lds_byte(int r, int c) { const int st = (r >> 4) * 2 + (c >> 5), rr = r & 15, cc = c & 31, ob = rr * 64 + cc * 2; return st * 1024 + (ob ^ (((ob >> 9) & 1) << 5)); }
__host__ __device__ __forceinline__ void stage_rc(int b, int& R, int& C) { const int st = b / 1024, sb = b % 1024, swz = sb ^ (((sb >> 9) & 1) << 5); R = (st >> 1) * 16 + swz / 64; C = (st & 1) * 32 + (swz % 64) / 2; }
__host__ __device__ __forceinline__ int perm32(int rho) { const int n = rho >> 4, i = rho & 15; return 8 * (i >> 2) + 4 * n + (i & 3); }

struct Unit { int pm, pn, e, rb, cnt; };
struct Gemm { const bf16_t* A; const bf16_t* Bt; int K; };

struct StaticOrder {
    int nM, nN, nwg, G, c;
    __device__ void init(int M, int N, int G_, int c_) { nM = M / BM; nN = N / BM; nwg = nM * nN; G = G_; c = c_; }
    __device__ __forceinline__ bool next(int i, Unit& u) const {
        const long L = (long)i * G + c; if (L >= nwg) return false;
        int wgid = (int)L; { const int q = nwg / NXCD, r = nwg % NXCD, xcd = wgid % NXCD, off = wgid / NXCD; wgid = (xcd < r ? xcd * (q + 1) : r * (q + 1) + (xcd - r) * q) + off; }
        const int nig = WGM * nN, gid = wgid / nig, fm = gid * WGM, gsz = (nM - fm) < WGM ? (nM - fm) : WGM;
        u.pm = fm + ((wgid % nig) % gsz); u.pn = (wgid % nig) / gsz; u.e = 0; u.rb = 0; u.cnt = 0; return true;
    }
    __device__ __forceinline__ unsigned row_off(const Unit&, int, int) const { return 0u; }
    __device__ __forceinline__ const int* gsrc() const { return nullptr; }
    __device__ __forceinline__ unsigned gsoff(const Unit&) const { return 0u; }
    __device__ __forceinline__ unsigned raw_off(const Unit&, int, int, unsigned) const { return 0u; }
};
struct ListOrder {
    const PG8_LAS int* list; int n;
    const GAS int* slot_dst; int cap; unsigned rowbytes;
    __device__ __forceinline__ bool next(int i, Unit& u) const {
        if (i >= n) return false;
        const PG8_LAS int* p = list + i * 8;
        u.pm = __builtin_amdgcn_readfirstlane(p[0]); u.pn = __builtin_amdgcn_readfirstlane(p[1]); u.e = __builtin_amdgcn_readfirstlane(p[2]);
        u.rb = __builtin_amdgcn_readfirstlane(p[3]); u.cnt = __builtin_amdgcn_readfirstlane(p[4]); return true;
    }
    __device__ __forceinline__ unsigned row_off(const Unit& u, int h, int R) const {
        const int pos = u.rb * 256 + h * 128 + R;
        int tok = 0; if (pos < u.cnt) tok = slot_dst[(size_t)u.e * cap + pos] >> 2;
        return (unsigned)tok * rowbytes;
    }
    __device__ __forceinline__ const int* gsrc() const { return (const int*)slot_dst; }
    __device__ __forceinline__ unsigned gsoff(const Unit& u) const { return (unsigned)u.e * (unsigned)cap * 4u; }
    __device__ __forceinline__ unsigned raw_off(const Unit& u, int h, int R, unsigned raw) const { const int pos = u.rb * 256 + h * 128 + R; return (pos < u.cnt ? (raw >> 2) : 0u) * rowbytes; }
};

typedef float f32x2c __attribute__((ext_vector_type(2)));
typedef __bf16 bf16x2c __attribute__((ext_vector_type(2)));
__device__ __forceinline__ unsigned cvt_pk_bf16(float lo, float hi) { const f32x2c v = {lo, hi}; const bf16x2c b = __builtin_convertvector(v, bf16x2c); return __builtin_bit_cast(unsigned, b); }

struct Pre2 { unsigned a, b; };
__device__ __forceinline__ unsigned pack_i8x4(float x0, float x1, float x2, float x3) {
    const unsigned y0 = __float_as_uint(x0 + 12582912.0f), y1 = __float_as_uint(x1 + 12582912.0f), y2 = __float_as_uint(x2 + 12582912.0f), y3 = __float_as_uint(x3 + 12582912.0f);
    return (y0 & 0xffu) | ((y1 & 0xffu) << 8) | ((y2 & 0xffu) << 16) | (y3 << 24);
}
struct EpiProj {
    static constexpr bool PERM = true, HAS_PRE = true; static constexpr int NVM = 16; typedef Pre2 Pre;
    bf16_t* O; int ldc; const GAS float* hs; const GAS unsigned* cmax;
    __device__ __forceinline__ Pre2 prefetch(const Unit& u, int t) const { Pre2 p; p.b = 0u;
        p.a = t < 256 ? __float_as_uint(hs[u.pm * BM + t]) : cmax[u.pn * BM + (t - 256)]; return p; }
    __device__ __forceinline__ void stash(const Pre2& p, PG8_LAS unsigned* scr, int t) const { scr[t] = p.a; }
    __device__ __forceinline__ void operator()(const i32x4 (&acc)[2][2][4][2], const Unit& u, int wr, int wc, int fr, int fq, PG8_LAS unsigned* scr) const {
        const int row0 = u.pm * BM + wr * 64 + fr, col0 = u.pn * BM + wc * 32 + 8 * fq;
        f32x4 cs[2][2];
#pragma unroll
        for (int bj = 0; bj < 2; ++bj)
#pragma unroll
            for (int n = 0; n < 2; ++n) cs[bj][n] = *(const PG8_LAS f32x4*)(scr + 256 + bj * HALF + wc * 32 + 8 * fq + 4 * n) * (1.0f / 127.0f);
#pragma unroll
        for (int ai = 0; ai < 2; ++ai)
#pragma unroll
            for (int m = 0; m < 4; ++m) { const int r = ai * HALF + wr * 64 + m * 16 + fr; const float rs = __uint_as_float(scr[r]); bf16_t* rowp = O + (size_t)(u.pm * BM + r) * ldc + col0;
#pragma unroll
                for (int bj = 0; bj < 2; ++bj) { const f32x4 v0 = __builtin_convertvector(acc[ai][bj][m][0], f32x4) * (cs[bj][0] * rs), v1 = __builtin_convertvector(acc[ai][bj][m][1], f32x4) * (cs[bj][1] * rs);
                    u32x4 w; w.x = cvt_pk_bf16(v0[0], v0[1]); w.y = cvt_pk_bf16(v0[2], v0[3]); w.z = cvt_pk_bf16(v1[0], v1[1]); w.w = cvt_pk_bf16(v1[2], v1[3]);
                    *(GAS u32x4*)(rowp + bj * HALF) = w; } }
        (void)row0;
    }
};
struct EpiMix {
    static constexpr bool PERM = true, HAS_PRE = false; static constexpr int NVM = 16; typedef Pre2 Pre;
    bf16_t* O;
    __device__ __forceinline__ Pre2 prefetch(const Unit&, int) const { return Pre2{0u, 0u}; }
    __device__ __forceinline__ void stash(const Pre2&, PG8_LAS unsigned*, int) const {}
    __device__ __forceinline__ void operator()(const f32x4 (&acc)[2][2][4][2], const Unit& u, int wr, int wc, int fr, int fq, PG8_LAS unsigned*) const {
        const int row0 = u.pm * BM + wr * 64 + fr, col0 = u.pn * BM + wc * 32 + 8 * fq;
#pragma unroll
        for (int ai = 0; ai < 2; ++ai)
#pragma unroll
            for (int m = 0; m < 4; ++m) { bf16_t* rowp = O + (size_t)(row0 + ai * HALF + m * 16) * 1024 + col0;
#pragma unroll
                for (int bj = 0; bj < 2; ++bj) { const f32x4 v0 = acc[ai][bj][m][0], v1 = acc[ai][bj][m][1];
                    u32x4 w; w.x = cvt_pk_bf16(v0[0], v0[1]); w.y = cvt_pk_bf16(v0[2], v0[3]); w.z = cvt_pk_bf16(v1[0], v1[1]); w.w = cvt_pk_bf16(v1[2], v1[3]);
                    *(GAS u32x4*)(rowp + bj * HALF) = w; } }
    }
};
constexpr float ACT_SC = 8.0f;
struct EpiSwiglu {
    static constexpr bool PERM = true, HAS_PRE = true; static constexpr int NVM = 4; typedef Pre2 Pre;
    unsigned char* act; const GAS float* bgu; const GAS float* slot_hs; const GAS unsigned* cmax; int cap;
    __device__ __forceinline__ Pre2 prefetch(const Unit& u, int t) const { Pre2 p; const int j = u.pn & 7;
        if (t < 256) { p.a = __float_as_uint(slot_hs[(size_t)u.e * cap + u.rb * 256 + t]); p.b = __float_as_uint(bgu[(size_t)u.e * 2048 + (t < 128 ? j * 128 + t : 1024 + j * 128 + (t - 128))]); }
        else { p.a = cmax[(size_t)u.e * 2048 + j * 256 + (t - 256)]; p.b = 0u; }
        return p; }
    __device__ __forceinline__ void stash(const Pre2& p, PG8_LAS unsigned* scr, int t) const { scr[t] = p.a; if (t < 256) scr[512 + t] = p.b; }
    __device__ __forceinline__ void operator()(const i32x4 (&acc)[2][2][4][2], const Unit& u, int wr, int wc, int fr, int fq, PG8_LAS unsigned* scr) const {
        const int j = u.pn & 7;
        const int row0 = u.pm * BM + wr * 64 + fr, c0 = j * 128 + wc * 32 + 8 * fq, cl = wc * 32 + 8 * fq;
        f32x4 bgv[2], buv[2], csg[2], csu[2];
        constexpr float C2 = 1.702f * 1.44269504f;
#pragma unroll
        for (int n = 0; n < 2; ++n) { bgv[n] = *(const PG8_LAS f32x4*)(scr + 512 + cl + 4 * n) * C2; buv[n] = *(const PG8_LAS f32x4*)(scr + 512 + 128 + cl + 4 * n);
            csg[n] = *(const PG8_LAS f32x4*)(scr + 256 + cl + 4 * n) * (C2 / 127.0f); csu[n] = *(const PG8_LAS f32x4*)(scr + 256 + 128 + cl + 4 * n) * (1.0f / 127.0f); }
#pragma unroll
        for (int ai = 0; ai < 2; ++ai)
#pragma unroll
            for (int mp = 0; mp < 4; mp += 2) { unsigned wp[2][2];
#pragma unroll
                for (int hm = 0; hm < 2; ++hm) { const int m = mp + hm; const int r = ai * HALF + wr * 64 + m * 16 + fr; const float rs = __uint_as_float(scr[r]); float o[8];
#pragma unroll
                    for (int n = 0; n < 2; ++n) { const f32x4 sgr = csg[n] * rs, sur = csu[n] * rs;
#pragma unroll
                        for (int q = 0; q < 4; ++q) { const float h = fminf(__builtin_fmaf((float)acc[ai][0][m][n][q], sgr[q], bgv[n][q]), 7.0f * C2), up = fminf(fmaxf(__builtin_fmaf((float)acc[ai][1][m][n][q], sur[q], buv[n][q]), -7.0f), 7.0f);
                            const float sg = __builtin_amdgcn_rcpf(1.0f + __builtin_amdgcn_exp2f(-h)); o[4 * n + q] = __builtin_fmaf(up, ACT_SC / C2, ACT_SC / C2) * (h * sg); } }
                    int w0 = __builtin_amdgcn_cvt_pk_fp8_f32(o[0], o[1], 0, false); w0 = __builtin_amdgcn_cvt_pk_fp8_f32(o[2], o[3], w0, true);
                    int w1 = __builtin_amdgcn_cvt_pk_fp8_f32(o[4], o[5], 0, false); w1 = __builtin_amdgcn_cvt_pk_fp8_f32(o[6], o[7], w1, true);
                    wp[hm][0] = (unsigned)w0; wp[hm][1] = (unsigned)w1; }
                { auto r0 = __builtin_amdgcn_permlane16_swap(wp[0][0], wp[1][0], false, false); wp[0][0] = r0[0]; wp[1][0] = r0[1];
                  auto r1 = __builtin_amdgcn_permlane16_swap(wp[0][1], wp[1][1], false, false); wp[0][1] = r1[0]; wp[1][1] = r1[1]; }
                const int odd = fq & 1;
                const size_t arow = (size_t)(row0 + ai * HALF + (mp + odd) * 16);
                *(GAS u32x4*)(act + arow * 1024 + (c0 - 8 * odd)) = (u32x4){wp[0][0], wp[0][1], wp[1][0], wp[1][1]};
                __builtin_amdgcn_sched_barrier(0); }
    }
};
struct Pre3 { unsigned a, b, c; };
constexpr float WDN_SC = 447.0f;
struct EpiDown {
    static constexpr bool PERM = true, HAS_PRE = true; static constexpr int NVM = 8; typedef Pre3 Pre;
    bf16_t* y4; int trash; const GAS float* bdn; const GAS int* slot_dst; const GAS float* slot_gate; const GAS unsigned* cmax; int cap;
    __device__ __forceinline__ Pre3 prefetch(const Unit& u, int t) const { Pre3 p;
        if (t < 256) { const size_t si = (size_t)u.e * cap + u.rb * 256 + t; p.a = (unsigned)slot_dst[si]; p.b = __float_as_uint(slot_gate[si]); p.c = 0u; }
        else { p.a = __float_as_uint(bdn[(size_t)u.e * 1024 + (u.pn & 3) * 256 + (t - 256)]); p.b = cmax[(size_t)u.e * 1024 + (u.pn & 3) * 256 + (t - 256)]; p.c = 0u; }
        return p; }
    __device__ __forceinline__ void stash(const Pre3& p, PG8_LAS unsigned* scr, int t) const { scr[t] = p.a; scr[512 + t] = p.b; }
    __device__ __forceinline__ void operator()(const f32x4 (&acc)[2][2][4][2], const Unit& u, int wr, int wc, int fr, int fq, PG8_LAS unsigned* scr) const {
        const int jn = u.pn & 3;
        const int c0 = jn * 256 + wc * 32 + 8 * fq, cl = wc * 32 + 8 * fq;
        f32x4 bv[2][2], cs[2][2];
#pragma unroll
        for (int bj = 0; bj < 2; ++bj)
#pragma unroll
            for (int n = 0; n < 2; ++n) { bv[bj][n] = *(const PG8_LAS f32x4*)(scr + 256 + bj * HALF + cl + 4 * n); cs[bj][n] = *(const PG8_LAS f32x4*)(scr + 768 + bj * HALF + cl + 4 * n) * (1.0f / (WDN_SC * ACT_SC)); }
#pragma unroll
        for (int ai = 0; ai < 2; ++ai)
#pragma unroll
            for (int mp = 0; mp < 4; mp += 2) { unsigned wq[2][2][2]; int dsts[2];
#pragma unroll
                for (int hm = 0; hm < 2; ++hm) { const int m = mp + hm; const int r = ai * HALF + wr * 64 + m * 16 + fr; const int pos = u.rb * 256 + r;
                    dsts[hm] = pos < u.cnt ? (int)scr[r] : trash + r; const float rg = __uint_as_float(scr[512 + r]) * 16.0f;
#pragma unroll
                    for (int bj = 0; bj < 2; ++bj) { f32x4 v0 = (acc[ai][bj][m][0] * cs[bj][0] + bv[bj][0]) * rg, v1 = (acc[ai][bj][m][1] * cs[bj][1] + bv[bj][1]) * rg;
#pragma unroll
                        for (int q = 0; q < 4; ++q) { v0[q] = fminf(fmaxf(v0[q], -448.0f), 448.0f); v1[q] = fminf(fmaxf(v1[q], -448.0f), 448.0f); }
                        int w0 = __builtin_amdgcn_cvt_pk_fp8_f32(v0[0], v0[1], 0, false); w0 = __builtin_amdgcn_cvt_pk_fp8_f32(v0[2], v0[3], w0, true);
                        int w1 = __builtin_amdgcn_cvt_pk_fp8_f32(v1[0], v1[1], 0, false); w1 = __builtin_amdgcn_cvt_pk_fp8_f32(v1[2], v1[3], w1, true);
                        wq[hm][bj][0] = (unsigned)w0; wq[hm][bj][1] = (unsigned)w1; } }
                const int odd = fq & 1; unsigned char* rowp = (unsigned char*)y4 + (size_t)(odd ? dsts[1] : dsts[0]) * 1024 + (c0 - 8 * odd);
#pragma unroll
                for (int bj = 0; bj < 2; ++bj) {
                    auto r0 = __builtin_amdgcn_permlane16_swap(wq[0][bj][0], wq[1][bj][0], false, false); auto r1 = __builtin_amdgcn_permlane16_swap(wq[0][bj][1], wq[1][bj][1], false, false);
                    *(GAS u32x4*)(rowp + bj * HALF) = (u32x4){(unsigned)r0[0], (unsigned)r1[0], (unsigned)r0[1], (unsigned)r1[1]}; } }
    }
};

template <int MODE> struct AccOf { typedef f32x4 type; };
template <> struct AccOf<1> { typedef i32x4 type; };
__device__ __forceinline__ f32x4 mma16(bf16x8 a, bf16x8 b, f32x4 c) { asm volatile("v_mfma_f32_16x16x32_bf16 %0, %1, %2, %0" : "+v"(c) : "v"(a), "v"(b)); return c; }
__device__ __forceinline__ i32x4 mma16(bf16x8 a, bf16x8 b, i32x4 c) { asm volatile("v_mfma_i32_16x16x64_i8 %0, %1, %2, %0" : "+v"(c) : "v"(a), "v"(b)); return c; }
typedef int i32x8 __attribute__((ext_vector_type(8)));
__device__ __forceinline__ f32x4 mma128(bf16x8 a0, bf16x8 a1, bf16x8 b0, bf16x8 b1, f32x4 c) {
    const i32x8 a = __builtin_shufflevector(__builtin_bit_cast(i32x4, a0), __builtin_bit_cast(i32x4, a1), 0, 1, 2, 3, 4, 5, 6, 7), b = __builtin_shufflevector(__builtin_bit_cast(i32x4, b0), __builtin_bit_cast(i32x4, b1), 0, 1, 2, 3, 4, 5, 6, 7);
    asm volatile("v_mfma_f32_16x16x128_f8f6f4 %0, %1, %2, %0" : "+v"(c) : "v"(a), "v"(b)); return c;
}
__device__ __forceinline__ f32x4 mma16z(bf16x8 a, bf16x8 b, f32x4) { f32x4 c; asm volatile("v_mfma_f32_16x16x32_bf16 %0, %1, %2, 0" : "=&v"(c) : "v"(a), "v"(b)); return c; }
__device__ __forceinline__ i32x4 mma16z(bf16x8 a, bf16x8 b, i32x4) { i32x4 c; asm volatile("v_mfma_i32_16x16x64_i8 %0, %1, %2, 0" : "=&v"(c) : "v"(a), "v"(b)); return c; }
__device__ __forceinline__ f32x4 mma128z(bf16x8 a0, bf16x8 a1, bf16x8 b0, bf16x8 b1) {
    const i32x8 a = __builtin_shufflevector(__builtin_bit_cast(i32x4, a0), __builtin_bit_cast(i32x4, a1), 0, 1, 2, 3, 4, 5, 6, 7), b = __builtin_shufflevector(__builtin_bit_cast(i32x4, b0), __builtin_bit_cast(i32x4, b1), 0, 1, 2, 3, 4, 5, 6, 7);
    f32x4 c; asm volatile("v_mfma_f32_16x16x128_f8f6f4 %0, %1, %2, 0" : "=&v"(c) : "v"(a), "v"(b)); return c;
}
template <class Epi, class Sched, bool GATHER, int MODE>
__device__ __forceinline__ void gemm_phase(PG8_LAS unsigned char* lds, PG8_LAS unsigned* scr, const Gemm g, const Sched& S, const Epi& E, int tid_in) {
    int tid = tid_in; asm volatile("" : "+v"(tid));
    const int wid = __builtin_amdgcn_readfirstlane(tid >> 6), lane = tid & 63, wr = wid >> 2, wc = wid & 3, fr = lane & 15, fq = lane >> 4;
    constexpr int K = MODE ? 512 : 1024, nt = K / BK;
    unsigned voffA[2], voffB[2];
#pragma unroll
    for (int i = 0; i < 2; ++i) { int R, C; stage_rc(tid * 16 + i * 8192, R, C); const int Rb = Epi::PERM ? ((R & ~31) + perm32(R & 31)) : R;
        voffA[i] = (unsigned)(R * K + C) * 2u; voffB[i] = (unsigned)(Rb * K + C) * 2u; }
    auto gather4 = [&](const Unit& uu) { u32x4 o; int tz = tid; asm volatile("" : "+v"(tz));
#pragma unroll
        for (int i = 0; i < 2; ++i) { int R, C; stage_rc(tz * 16 + i * 8192, R, C); o[i] = S.row_off(uu, 0, R) + (unsigned)C * 2u; o[2 + i] = S.row_off(uu, 1, R) + (unsigned)C * 2u; }
        return o; };
    auto gather_issue = [&](const Unit& uu) { int tz = tid; asm volatile("" : "+v"(tz));
        const __amdgpu_buffer_rsrc_t rs = __builtin_amdgcn_make_buffer_rsrc((void*)S.gsrc(), 0, (int)0xFFFFFFFFu, 0x00020000); const unsigned so = S.gsoff(uu);
#pragma unroll
        for (int i = 0; i < 2; ++i) { int R, C; stage_rc(tz * 16 + i * 8192, R, C);
#pragma unroll
            for (int h = 0; h < 2; ++h) __builtin_amdgcn_raw_ptr_buffer_load_lds(rs, (PG8_LAS void*)((PG8_LAS unsigned char*)(scr + 1024) + (2 * h + i) * 2048 + wid * 256), 4, (int)((unsigned)(uu.rb * 256 + h * 128 + R) * 4u), (int)so, 0, 0); } };
    auto gather_read = [&](const Unit& uu) { u32x4 o; int tz = tid; asm volatile("" : "+v"(tz));
#pragma unroll
        for (int i = 0; i < 2; ++i) { int R, C; stage_rc(tz * 16 + i * 8192, R, C);
#pragma unroll
            for (int h = 0; h < 2; ++h) o[2 * h + i] = S.raw_off(uu, h, R, *((const PG8_LAS unsigned*)(scr + 1024) + (2 * h + i) * 512 + tz)) + (unsigned)C * 2u; }
        return o; };
    constexpr unsigned kstep = (unsigned)(BK * 2);
    constexpr unsigned hstep = (unsigned)HALF * K * 2;
    constexpr unsigned tstep = 2 * hstep;
    constexpr unsigned hstepA = GATHER ? 0u : hstep;
    const __amdgpu_buffer_rsrc_t baseA = __builtin_amdgcn_make_buffer_rsrc((void*)g.A, 0, (int)0xFFFFFFFFu, 0x00020000), baseB = __builtin_amdgcn_make_buffer_rsrc((void*)g.Bt, 0, (int)0xFFFFFFFFu, 0x00020000);
    const unsigned ldsw = (unsigned)wid * 1024u;
    const int aoff = lds_byte(wr * 64 + fr, fq * 8), boff = lds_byte(wc * 32 + fr, fq * 8);
#define PG8_SA(b, h) (((b) * 2 + (h)) * HTB)
#define PG8_SB(b, h) ((4 + (b) * 2 + (h)) * HTB)
#define PG8_STAGE(bufoff, base, uoff, voff) do { _Pragma("unroll") for (int _i = 0; _i < 2; ++_i) \
        __builtin_amdgcn_raw_ptr_buffer_load_lds((base), (PG8_LAS void*)(lds + (bufoff) + ldsw + _i * 8192), 16, (int)(voff)[_i], (int)(uoff), 0, 0); } while (0)
#define PG8_LDA(dst, b, h) do { _Pragma("unroll") for (int m = 0; m < 4; ++m) _Pragma("unroll") for (int k = 0; k < 2; ++k) dst[m][k] = *(const PG8_LAS bf16x8*)(lds + PG8_SA(b, h) + aoff + m * 2048 + k * 1024); } while (0)
#define PG8_LDB(dst, b, h) do { _Pragma("unroll") for (int n = 0; n < 2; ++n) _Pragma("unroll") for (int k = 0; k < 2; ++k) dst[n][k] = *(const PG8_LAS bf16x8*)(lds + PG8_SB(b, h) + boff + n * 2048 + k * 1024); } while (0)
#define PG8_MMA(ai, bj, At, Bt) do { __builtin_amdgcn_s_setprio(1); _Pragma("unroll") for (int m = 0; m < 4; ++m) _Pragma("unroll") for (int n = 0; n < 2; ++n) { \
        if constexpr (MODE == 2) acc[ai][bj][m][n] = mma128(Bt[n][0], Bt[n][1], At[m][0], At[m][1], acc[ai][bj][m][n]); \
        else { _Pragma("unroll") for (int k = 0; k < 2; ++k) acc[ai][bj][m][n] = mma16(Bt[n][k], At[m][k], acc[ai][bj][m][n]); } } __builtin_amdgcn_s_setprio(0); } while (0)
#define PG8_MMAZ(ai, bj, At, Bt) do { __builtin_amdgcn_s_setprio(1); _Pragma("unroll") for (int m = 0; m < 4; ++m) _Pragma("unroll") for (int n = 0; n < 2; ++n) { \
        if constexpr (MODE == 2) acc[ai][bj][m][n] = mma128z(Bt[n][0], Bt[n][1], At[m][0], At[m][1]); \
        else { acc[ai][bj][m][n] = mma16z(Bt[n][0], At[m][0], acc[ai][bj][m][n]); acc[ai][bj][m][n] = mma16(Bt[n][1], At[m][1], acc[ai][bj][m][n]); } } __builtin_amdgcn_s_setprio(0); } while (0)
#define PG8_WAIT_V(n) asm volatile("s_waitcnt vmcnt(" #n ")" ::: "memory")
#define PG8_WAIT_VN(n) asm volatile("s_waitcnt vmcnt(%0)" :: "n"(n) : "memory")
#define PG8_WAIT_L(n) asm volatile("s_waitcnt lgkmcnt(" #n ")" ::: "memory")
#define PG8_BAR __builtin_amdgcn_s_barrier()
#define PG8_SCHED __builtin_amdgcn_sched_barrier(0)
    Unit cur, nxt; int ui = 0;
    if (!S.next(0, cur)) return;
    typedef typename AccOf<MODE>::type AccT;
    AccT acc[2][2][4][2];
    bf16x8 At[4][2], B0[2][2], B1[2][2];
    unsigned c0[2], c1[2];
    if (GATHER) { gather_issue(cur); asm volatile("s_waitcnt vmcnt(0)" ::: "memory");
        const u32x4 o = gather_read(cur); c0[0] = o[0]; c0[1] = o[1]; c1[0] = o[2]; c1[1] = o[3]; }
    else { c0[0] = voffA[0]; c0[1] = voffA[1]; c1[0] = voffA[0]; c1[1] = voffA[1]; }
    unsigned cA = GATHER ? 0u : (unsigned)cur.pm * tstep, cB = (unsigned)cur.pn * tstep;
    PG8_STAGE(PG8_SB(0, 0), baseB, cB, voffB); PG8_STAGE(PG8_SB(0, 1), baseB, cB + hstep, voffB); PG8_STAGE(PG8_SA(0, 0), baseA, cA, c0); PG8_STAGE(PG8_SA(0, 1), baseA, cA + hstepA, c1);
    if (wr == 1) PG8_BAR;
    PG8_WAIT_V(2); PG8_BAR;
    PG8_STAGE(PG8_SB(1, 0), baseB, cB + kstep, voffB); PG8_STAGE(PG8_SA(1, 0), baseA, cA + kstep, c0); PG8_STAGE(PG8_SB(1, 1), baseB, cB + hstep + kstep, voffB);
    PG8_WAIT_V(6); PG8_BAR;
    for (;;) {
        const typename Epi::Pre pre = E.prefetch(cur, tid);
        const bool has_next = S.next(ui + 1, nxt);
        const unsigned nA = has_next ? (GATHER ? 0u : (unsigned)nxt.pm * tstep) : cA, nB = has_next ? (unsigned)nxt.pn * tstep : cB;
        if (GATHER && has_next) gather_issue(nxt);
        {
            const unsigned a1 = cA + kstep, a2 = cA + 2u * kstep, b2 = cB + 2u * kstep, a3 = a2 + kstep, b3 = b2 + kstep;
            PG8_LDB(B0, 0, 0); PG8_LDB(B1, 0, 1); PG8_SCHED; PG8_LDA(At, 0, 0); PG8_STAGE(PG8_SA(1, 1), baseA, a1 + hstepA, c1);
            if (ui > 0) PG8_WAIT_VN(8 + Epi::NVM); else PG8_WAIT_V(8);
            PG8_WAIT_L(0); PG8_BAR; PG8_MMAZ(0, 0, At, B0); PG8_MMAZ(0, 1, At, B1); PG8_BAR; PG8_SCHED;
            PG8_LDA(At, 0, 1); PG8_STAGE(PG8_SB(0, 0), baseB, b2, voffB); PG8_STAGE(PG8_SB(0, 1), baseB, b2 + hstep, voffB); PG8_STAGE(PG8_SA(0, 0), baseA, a2, c0);
            if (ui > 0) PG8_WAIT_VN(8 + Epi::NVM); else PG8_WAIT_V(8);
            PG8_WAIT_L(0); PG8_BAR; PG8_MMAZ(1, 0, At, B0); PG8_MMAZ(1, 1, At, B1); PG8_BAR; PG8_SCHED;
            PG8_LDB(B0, 1, 0); PG8_LDB(B1, 1, 1); PG8_SCHED; PG8_LDA(At, 1, 0); PG8_STAGE(PG8_SA(0, 1), baseA, a2 + hstepA, c1);
            PG8_WAIT_V(8); PG8_WAIT_L(0); PG8_BAR; PG8_MMA(0, 0, At, B0); PG8_MMA(0, 1, At, B1); PG8_BAR; PG8_SCHED;
            PG8_LDA(At, 1, 1); PG8_STAGE(PG8_SB(1, 0), baseB, b3, voffB); PG8_STAGE(PG8_SB(1, 1), baseB, b3 + hstep, voffB); PG8_STAGE(PG8_SA(1, 0), baseA, a3, c0);
            PG8_WAIT_V(8); PG8_WAIT_L(0); PG8_BAR; PG8_MMA(1, 0, At, B0); PG8_MMA(1, 1, At, B1); PG8_BAR; PG8_SCHED;
        }
#pragma unroll 1
        for (int t = 2; t < nt; t += 2) {
            const bool last = (t == nt - 2);
            const int tt = __builtin_amdgcn_readfirstlane(t);
            const unsigned a1 = cA + (unsigned)(tt + 1) * kstep;
            const unsigned a2 = last ? nA : cA + (unsigned)(tt + 2) * kstep, b2 = last ? nB : cB + (unsigned)(tt + 2) * kstep;
            const unsigned a3 = a2 + kstep, b3 = b2 + kstep;
            unsigned s0[2], s1[2];
            if (GATHER && last && has_next) { const u32x4 nx = gather_read(nxt); s0[0] = nx[0]; s0[1] = nx[1]; s1[0] = nx[2]; s1[1] = nx[3]; }
            else { s0[0] = c0[0]; s0[1] = c0[1]; s1[0] = c1[0]; s1[1] = c1[1]; }
            PG8_LDB(B0, 0, 0); PG8_LDB(B1, 0, 1); PG8_SCHED; PG8_LDA(At, 0, 0); PG8_STAGE(PG8_SA(1, 1), baseA, a1 + hstepA, c1);
            PG8_WAIT_V(8); PG8_WAIT_L(0); PG8_BAR; PG8_MMA(0, 0, At, B0); PG8_MMA(0, 1, At, B1); PG8_BAR; PG8_SCHED;
            PG8_LDA(At, 0, 1); PG8_STAGE(PG8_SB(0, 0), baseB, b2, voffB); PG8_STAGE(PG8_SB(0, 1), baseB, b2 + hstep, voffB); PG8_STAGE(PG8_SA(0, 0), baseA, a2, s0);
            PG8_WAIT_V(8); PG8_WAIT_L(0); PG8_BAR; PG8_MMA(1, 0, At, B0); PG8_MMA(1, 1, At, B1); PG8_BAR; PG8_SCHED;
            PG8_LDB(B0, 1, 0); PG8_LDB(B1, 1, 1); PG8_SCHED; PG8_LDA(At, 1, 0); PG8_STAGE(PG8_SA(0, 1), baseA, a2 + hstepA, s1);
            PG8_WAIT_V(8); PG8_WAIT_L(0); PG8_BAR; PG8_MMA(0, 0, At, B0); PG8_MMA(0, 1, At, B1); PG8_BAR; PG8_SCHED;
            PG8_LDA(At, 1, 1); PG8_STAGE(PG8_SB(1, 0), baseB, b3, voffB); PG8_STAGE(PG8_SB(1, 1), baseB, b3 + hstep, voffB); PG8_STAGE(PG8_SA(1, 0), baseA, a3, s0);
            PG8_WAIT_V(8); PG8_WAIT_L(0); PG8_BAR; PG8_MMA(1, 0, At, B0); PG8_MMA(1, 1, At, B1); PG8_BAR; PG8_SCHED;
        }
        asm volatile("s_nop 15\n\ts_nop 7" ::: "memory");
        if (wr == 0) PG8_BAR;
        if (Epi::HAS_PRE) { E.stash(pre, scr, tid); PG8_WAIT_L(0); PG8_BAR; }
        { int tz = tid; asm volatile("" : "+v"(tz));
          const int lz = tz & 63, wz = tz >> 6; E(acc, cur, wz >> 2, wz & 3, lz & 15, lz >> 4, scr); }
        if (!has_next) break;
        cur = nxt; cA = nA; cB = nB; ++ui;
        if (GATHER) { const u32x4 nx = gather_read(cur); c0[0] = nx[0]; c0[1] = nx[1]; c1[0] = nx[2]; c1[1] = nx[3]; }
        if (wr == 1) PG8_BAR;
    }
    PG8_WAIT_V(0);
    PG8_BAR;
#undef PG8_SA
#undef PG8_SB
#undef PG8_STAGE
#undef PG8_LDA
#undef PG8_LDB
#undef PG8_MMA
#undef PG8_MMAZ
#undef PG8_WAIT_V
#undef PG8_WAIT_VN
#undef PG8_WAIT_L
#undef PG8_BAR
#undef PG8_SCHED
}
}

constexpr int NWAVES = 8;
constexpr int BATCH = 32, SEQ = 2048, D = 1024, DEPTH = 2;
constexpr int M = BATCH * SEQ;
constexpr int NPROJ = 3344, NPROJ_PAD = 3584;
constexpr int NEXP = 32, TOPK = 4, DFF = 1024;
constexpr int CAP = M;
constexpr float LN_EPS = 1e-5f, RMS_EPS = 1e-6f;
constexpr float ALPHA = 1.4142135623730951f;
constexpr int C_GQ = 0, C_GK = 256, C_GV = 512, C_GLG = 1024, C_GOG = 1280, C_HQ = 1792, C_HF = 2048, C_HI = 2304, C_HOG = 2560, C_CB = 2816, C_CC = 3072, C_CH = 3328;
constexpr int SRC_GLR = 1024, GLR_RANK = 16;

constexpr size_t MiB = 1u << 20;
constexpr size_t WS_CTL = 0, CTL_ZERO_BYTES = 1 * MiB;
constexpr size_t W_IN_B = (size_t)NPROJ_PAD * D * 2, W_OUT_B = (size_t)D * D * 2, W_GU_B = (size_t)NEXP * 2048 * D * 2, W_DN_B = (size_t)NEXP * D * DFF * 2;
constexpr size_t W_LAYER_B = W_IN_B + W_OUT_B + W_GU_B + W_DN_B;
constexpr size_t WS_W = 2 * MiB;
constexpr size_t WS_HB = 404 * MiB;
constexpr size_t WS_R1 = 532 * MiB;
constexpr size_t WS_MIX = WS_R1, WS_PROJ = WS_R1 + 128 * MiB, WS_Y = WS_PROJ + 448 * MiB, WS_ACT = WS_PROJ;
constexpr size_t ACT_ROWS = (size_t)M * 4 + NEXP * 256;
static_assert(ACT_ROWS * 1024 <= 576 * MiB, "fp8 activations [ACT_ROWS][1024] fit the proj|Y overlay");
constexpr size_t WS_Y4 = 1236 * MiB;
constexpr size_t WS_SLOT = 1748 * MiB;
constexpr size_t WS_END = 1772 * MiB;
static_assert((size_t)(M * 4 + NEXP * 256) * 1024 * 2 <= 576 * MiB, "act fits the proj|Y region");
constexpr int CW_BAR = 4096;
constexpr int CW_CNT = 16384;
constexpr int CW_CMAX_IN = 65536;
constexpr int CW_CMAX_GU = 65536 + 8192;
static_assert((CW_CMAX_GU + DEPTH * NEXP * 2048) * 4 <= (int)CTL_ZERO_BYTES, "CTL words inside the memset region");
constexpr int CW_CMAX_DN = 262144;
static_assert((size_t)(CW_CMAX_DN + DEPTH * NEXP * 1024) * 4 <= 2 * MiB, "W_down column maxima fit below the weight copies");
constexpr size_t WS_HS = WS_HB + 64 * MiB;

constexpr int RING_BYTES = 131072;
constexpr int MISC_OFF = RING_BYTES;
constexpr int ULIST_OFF = RING_BYTES + 256;
constexpr int TOK_OFF = RING_BYTES + 256 + 2048;
constexpr int LDS_BYTES = 147456;
static_assert(TOK_OFF + 3 * 4096 + 256 + 1024 <= LDS_BYTES, "LDS map");

typedef unsigned short bf16;
typedef unsigned v4u __attribute__((ext_vector_type(4)));
typedef unsigned v2u __attribute__((ext_vector_type(2)));
typedef float f32x4 __attribute__((ext_vector_type(4)));
typedef GAS unsigned gu32;
#define RLX_AGENT __ATOMIC_RELAXED, __HIP_MEMORY_SCOPE_AGENT
#define LDS_WAIT() asm volatile("s_waitcnt lgkmcnt(0)" ::: "memory")
typedef float f32x2_t __attribute__((ext_vector_type(2)));
typedef __bf16 bf16x2_t __attribute__((ext_vector_type(2)));
__device__ __forceinline__ unsigned pk2(float lo, float hi) { const f32x2_t v = {lo, hi}; const bf16x2_t b = __builtin_convertvector(v, bf16x2_t); return __builtin_bit_cast(unsigned, b); }
__device__ __forceinline__ unsigned f2bf(float f) { return pk2(f, f) & 0xffffu; }
using pg8::pack_i8x4;
__device__ __forceinline__ float bf2f(unsigned short b) { return __builtin_bit_cast(float, ((unsigned)b) << 16); }
__device__ __forceinline__ float bflo(unsigned w) { return __builtin_bit_cast(float, w << 16); }
__device__ __forceinline__ float bfhi(unsigned w) { return __builtin_bit_cast(float, w & 0xffff0000u); }

#define XB_TMO      128
#define XB_XCNT(j)  (256  + 64 * (j))
#define XB_XSUB(j)  (1280 + 64 * (j))
#define XB_XGEN(j)  (2304 + 64 * (j))
#define XB_TOP      3328
#define XB_TOPGEN   3392
#define XCD_BAR_WORDS 3456
#define XB_SPIN_CAP (1u << 18)
__device__ __forceinline__ unsigned xb_ld(unsigned* p)              { return __hip_atomic_load(p, __ATOMIC_RELAXED, __HIP_MEMORY_SCOPE_AGENT); }
__device__ __forceinline__ unsigned xb_add(unsigned* p, unsigned v) { return __hip_atomic_fetch_add(p, v, __ATOMIC_RELAXED, __HIP_MEMORY_SCOPE_AGENT); }
__device__ __forceinline__ unsigned xb_xcc_id() { return (unsigned)__builtin_amdgcn_s_getreg((3 << 11) | 20) & 0xFu; }
#define XB_SPIN(cond, bar) do { unsigned _sp = 0; while (cond) { __builtin_amdgcn_s_sleep(1); \
    if ((++_sp & 255u) == 0u) { if (xb_ld(&(bar)[XB_TMO])) break; if (_sp > XB_SPIN_CAP) { atomicAdd(&(bar)[XB_TMO], 1u); break; } } } } while (0)
struct XcdBarrier { unsigned* bar; unsigned x; volatile LAS unsigned* st; };
__device__ __forceinline__ XcdBarrier xcd_barrier_post(unsigned* bar, volatile LAS unsigned* st) {
    XcdBarrier b; b.bar = bar; b.x = xb_xcc_id(); b.st = st;
    if (threadIdx.x == 0) (void)xb_add(&bar[XB_XCNT(b.x)], 1u);
    return b;
}
__device__ __forceinline__ void xcd_barrier_complete(unsigned* bar, unsigned x, unsigned& nloc, unsigned& nx) {
    const unsigned G = gridDim.x * gridDim.y * gridDim.z;
    unsigned sum, cnt, mine, sp = 0u;
    for (;;) {
        sum = 0u; cnt = 0u; mine = 0u;
#pragma unroll
        for (unsigned j = 0; j < 16; ++j) { const unsigned c = xb_ld(&bar[XB_XCNT(j)]); sum += c; cnt += (c > 0u) ? 1u : 0u; mine = (j == x) ? c : mine; }
        if (sum == G) break;
        __builtin_amdgcn_s_sleep(1);
        if ((++sp & 255u) == 0u) { if (xb_ld(&bar[XB_TMO])) break; if (sp > XB_SPIN_CAP) { atomicAdd(&bar[XB_TMO], 1u); break; } }
    }
    nloc = mine > 0u ? mine : 1u; nx = cnt > 0u ? cnt : 1u;
}
__device__ __forceinline__ void xcd_barrier(const XcdBarrier& b, bool leader) {
    asm volatile("s_waitcnt vmcnt(0)" ::: "memory");
    __syncthreads();
    if (leader) {
        unsigned* bar = b.bar;
        __builtin_amdgcn_s_waitcnt(0);
        unsigned nloc = b.st[0], nx = b.st[1];
        if (nloc == 0u) { xcd_barrier_complete(bar, b.x, nloc, nx); b.st[0] = nloc; b.st[1] = nx; }
        const unsigned old = xb_add(&bar[XB_XSUB(b.x)], 1u);
        const unsigned gen = old / nloc;
        if (old + 1u == (gen + 1u) * nloc) {
            __builtin_amdgcn_fence(__ATOMIC_RELEASE, "agent");
            asm volatile("s_waitcnt vmcnt(0)" ::: "memory");
            const unsigned og = xb_add(&bar[XB_TOP], 1u);
            const unsigned tg = og / nx;
            if (og + 1u == (tg + 1u) * nx) xb_add(&bar[XB_TOPGEN], 1u);
            else XB_SPIN(xb_ld(&bar[XB_TOPGEN]) == tg, bar);
            __builtin_amdgcn_fence(__ATOMIC_ACQUIRE, "agent");
            xb_add(&bar[XB_XGEN(b.x)], 1u);
            asm volatile("s_waitcnt vmcnt(0)" ::: "memory");
        } else {
            XB_SPIN(xb_ld(&bar[XB_XGEN(b.x)]) == gen, bar);
            __builtin_amdgcn_fence(__ATOMIC_ACQUIRE, "agent");
            asm volatile("s_waitcnt vmcnt(0)" ::: "memory");
        }
    }
    __syncthreads();
}

struct Frame {
    LAS unsigned char* lds;
    volatile LAS unsigned* MISC;
    gu32* ctl;
    int tid, lane, wave, vcu, G;
    const __attribute__((address_space(4))) unsigned char* ka;
    float* H;
    unsigned char* ws;
};
__device__ __forceinline__ const GAS float* inp(const Frame& F, int i) { return (const GAS float*)*(const float* const __attribute__((address_space(4)))*)(F.ka + 8 * i); }
__device__ __forceinline__ bf16* w_in_t(Frame& F, int l)  { return (bf16*)(F.ws + WS_W + (size_t)l * W_LAYER_B); }
__device__ __forceinline__ bf16* w_out_t(Frame& F, int l) { return (bf16*)(F.ws + WS_W + (size_t)l * W_LAYER_B + W_IN_B); }
__device__ __forceinline__ bf16* w_gu_t(Frame& F, int l)  { return (bf16*)(F.ws + WS_W + (size_t)l * W_LAYER_B + W_IN_B + W_OUT_B); }
__device__ __forceinline__ bf16* w_dn_t(Frame& F, int l)  { return (bf16*)(F.ws + WS_W + (size_t)l * W_LAYER_B + W_IN_B + W_OUT_B + W_GU_B); }

__device__ __forceinline__ void lds_barrier() { asm volatile("s_waitcnt lgkmcnt(0)" ::: "memory"); __builtin_amdgcn_s_barrier(); asm volatile("" ::: "memory"); }
template <int CTRL, int RM> __device__ __forceinline__ float dpp_mv(float v) { return __builtin_bit_cast(float, __builtin_amdgcn_update_dpp(__builtin_bit_cast(int, v), __builtin_bit_cast(int, v), CTRL, RM, 0xf, false)); }
__device__ __forceinline__ float wave_sum(float v) {
    v += dpp_mv<0xb1, 0xf>(v); v += dpp_mv<0x4e, 0xf>(v); v += dpp_mv<0x124, 0xf>(v); v += dpp_mv<0x128, 0xf>(v); v += dpp_mv<0x142, 0xa>(v); v += dpp_mv<0x143, 0xc>(v);
    return __builtin_bit_cast(float, __builtin_amdgcn_readlane(__builtin_bit_cast(int, v), 63));
}
__device__ __forceinline__ float wave_max(float v) {
    v = fmaxf(v, dpp_mv<0xb1, 0xf>(v)); v = fmaxf(v, dpp_mv<0x4e, 0xf>(v)); v = fmaxf(v, dpp_mv<0x124, 0xf>(v)); v = fmaxf(v, dpp_mv<0x128, 0xf>(v)); v = fmaxf(v, dpp_mv<0x142, 0xa>(v)); v = fmaxf(v, dpp_mv<0x143, 0xc>(v));
    return __builtin_bit_cast(float, __builtin_amdgcn_readlane(__builtin_bit_cast(int, v), 63));
}
__device__ __forceinline__ float xmax16(float v) { const unsigned u = __builtin_bit_cast(unsigned, v); auto r = __builtin_amdgcn_permlane16_swap(u, u, false, false); return fmaxf(__builtin_bit_cast(float, (unsigned)r[0]), __builtin_bit_cast(float, (unsigned)r[1])); }

template <int MODE>
__device__ __forceinline__ void p0_transpose_item(const GAS float* W, int K, int N, bf16* WT, LAS float* scr, int item, int lane) {
    const int nblk = (N + 31) / 32, kb = item / nblk, nb = item % nblk, k0 = 64 * kb, n0 = 32 * nb;
    const bool nok = (n0 + (lane & 31)) < N;
#pragma unroll 8
    for (int i = 0; i < 32; ++i) { const int kk = 2 * i + (lane >> 5); scr[kk * 33 + (lane & 31)] = nok ? W[(size_t)(k0 + kk) * N + n0 + (lane & 31)] : 0.f; }
    LDS_WAIT(); asm volatile("" ::: "memory");
    const int c = lane & 7;
#pragma unroll
    for (int j = 0; j < 4; ++j) { const int n = (lane >> 3) + 8 * j; const LAS float* s = scr + (8 * c) * 33 + n;
        v4u o; o.x = pk2(s[0 * 33], s[1 * 33]); o.y = pk2(s[2 * 33], s[3 * 33]); o.z = pk2(s[4 * 33], s[5 * 33]); o.w = pk2(s[6 * 33], s[7 * 33]);
        const int ns = n0 + n;
        int nd = ns;
        if (MODE == 1) { const int half = ns >> 10, cc = ns & 1023; nd = (cc >> 7) * 256 + half * 128 + (cc & 127); }
        if (ns < N) *(GAS v4u*)(WT + (size_t)nd * K + k0 + 8 * c) = o; }
    LDS_WAIT(); asm volatile("" ::: "memory");
}
__device__ __forceinline__ void ln_row(f32x4 (&v)[4], const GAS float* g, const GAS float* b, int lane) {
    float s = 0.f;
#pragma unroll
    for (int j = 0; j < 4; ++j) s += (v[j].x + v[j].y) + (v[j].z + v[j].w);
    const float mean = wave_sum(s) * (1.f / D); float s2 = 0.f;
#pragma unroll
    for (int j = 0; j < 4; ++j) { v[j] = v[j] - mean; s2 += (v[j].x * v[j].x + v[j].y * v[j].y) + (v[j].z * v[j].z + v[j].w * v[j].w); }
    const float rstd = __builtin_amdgcn_rsqf(wave_sum(s2) * (1.f / D) + LN_EPS);
#pragma unroll
    for (int j = 0; j < 4; ++j) { const f32x4 gg = *(const GAS f32x4*)(g + 4 * lane + 256 * j), bb = *(const GAS f32x4*)(b + 4 * lane + 256 * j); v[j] = v[j] * rstd * gg + bb; }
}
__device__ __forceinline__ float store_row_q(const f32x4 (&v)[4], GAS signed char* qrow, GAS float* hsm, int lane) {
    float mx = 0.f;
#pragma unroll
    for (int j = 0; j < 4; ++j) mx = fmaxf(fmaxf(mx, fmaxf(fabsf(v[j].x), fabsf(v[j].y))), fmaxf(fabsf(v[j].z), fabsf(v[j].w)));
    mx = wave_max(mx); const float inv = mx > 0.f ? 127.0f * __builtin_amdgcn_rcpf(mx) : 0.f;
#pragma unroll
    for (int j = 0; j < 4; ++j) *(GAS unsigned*)(qrow + 4 * lane + 256 * j) = pack_i8x4(v[j].x * inv, v[j].y * inv, v[j].z * inv, v[j].w * inv);
    if (lane == 0) *hsm = mx * (1.0f / 127.0f);
    return mx * (1.0f / 127.0f);
}
__device__ __forceinline__ void wave_sum2(float& x, float& y) {
    x += dpp_mv<0xb1, 0xf>(x); y += dpp_mv<0xb1, 0xf>(y); x += dpp_mv<0x4e, 0xf>(x); y += dpp_mv<0x4e, 0xf>(y); x += dpp_mv<0x124, 0xf>(x); y += dpp_mv<0x124, 0xf>(y);
    x += dpp_mv<0x128, 0xf>(x); y += dpp_mv<0x128, 0xf>(y); x += dpp_mv<0x142, 0xa>(x); y += dpp_mv<0x142, 0xa>(y); x += dpp_mv<0x143, 0xc>(x); y += dpp_mv<0x143, 0xc>(y);
    x = __builtin_bit_cast(float, __builtin_amdgcn_readlane(__builtin_bit_cast(int, x), 63)); y = __builtin_bit_cast(float, __builtin_amdgcn_readlane(__builtin_bit_cast(int, y), 63));
}
__device__ __forceinline__ void wave_max2(float& x, float& y) {
    x = fmaxf(x, dpp_mv<0xb1, 0xf>(x)); y = fmaxf(y, dpp_mv<0xb1, 0xf>(y)); x = fmaxf(x, dpp_mv<0x4e, 0xf>(x)); y = fmaxf(y, dpp_mv<0x4e, 0xf>(y)); x = fmaxf(x, dpp_mv<0x124, 0xf>(x)); y = fmaxf(y, dpp_mv<0x124, 0xf>(y));
    x = fmaxf(x, dpp_mv<0x128, 0xf>(x)); y = fmaxf(y, dpp_mv<0x128, 0xf>(y)); x = fmaxf(x, dpp_mv<0x142, 0xa>(x)); y = fmaxf(y, dpp_mv<0x142, 0xa>(y)); x = fmaxf(x, dpp_mv<0x143, 0xc>(x)); y = fmaxf(y, dpp_mv<0x143, 0xc>(y));
    x = __builtin_bit_cast(float, __builtin_amdgcn_readlane(__builtin_bit_cast(int, x), 63)); y = __builtin_bit_cast(float, __builtin_amdgcn_readlane(__builtin_bit_cast(int, y), 63));
}
__device__ __forceinline__ void ln_row2(f32x4 (&a)[4], f32x4 (&c)[4], const GAS float* g, const GAS float* b, int lane) {
    float sa = 0.f, sc = 0.f;
#pragma unroll
    for (int j = 0; j < 4; ++j) { sa += (a[j].x + a[j].y) + (a[j].z + a[j].w); sc += (c[j].x + c[j].y) + (c[j].z + c[j].w); }
    wave_sum2(sa, sc); const float ma = sa * (1.f / D), mc = sc * (1.f / D); float qa = 0.f, qc = 0.f;
#pragma unroll
    for (int j = 0; j < 4; ++j) { a[j] = a[j] - ma; c[j] = c[j] - mc; qa += (a[j].x * a[j].x + a[j].y * a[j].y) + (a[j].z * a[j].z + a[j].w * a[j].w); qc += (c[j].x * c[j].x + c[j].y * c[j].y) + (c[j].z * c[j].z + c[j].w * c[j].w); }
    wave_sum2(qa, qc); const float ra = __builtin_amdgcn_rsqf(qa * (1.f / D) + LN_EPS), rc = __builtin_amdgcn_rsqf(qc * (1.f / D) + LN_EPS);
#pragma unroll
    for (int j = 0; j < 4; ++j) { const f32x4 gg = *(const GAS f32x4*)(g + 4 * lane + 256 * j), bb = *(const GAS f32x4*)(b + 4 * lane + 256 * j); a[j] = a[j] * ra * gg + bb; c[j] = c[j] * rc * gg + bb; }
}
__device__ __forceinline__ void store_row_q2(const f32x4 (&a)[4], const f32x4 (&c)[4], GAS signed char* qa, GAS signed char* qc, GAS float* hsa, GAS float* hsc, int lane, float& sca, float& scc) {
    float xa = 0.f, xc = 0.f;
#pragma unroll
    for (int j = 0; j < 4; ++j) { xa = fmaxf(fmaxf(xa, fmaxf(fabsf(a[j].x), fabsf(a[j].y))), fmaxf(fabsf(a[j].z), fabsf(a[j].w))); xc = fmaxf(fmaxf(xc, fmaxf(fabsf(c[j].x), fabsf(c[j].y))), fmaxf(fabsf(c[j].z), fabsf(c[j].w))); }
    wave_max2(xa, xc); const float ia = xa > 0.f ? 127.0f * __builtin_amdgcn_rcpf(xa) : 0.f, ic = xc > 0.f ? 127.0f * __builtin_amdgcn_rcpf(xc) : 0.f;
#pragma unroll
    for (int j = 0; j < 4; ++j) { *(GAS unsigned*)(qa + 4 * lane + 256 * j) = pack_i8x4(a[j].x * ia, a[j].y * ia, a[j].z * ia, a[j].w * ia); *(GAS unsigned*)(qc + 4 * lane + 256 * j) = pack_i8x4(c[j].x * ic, c[j].y * ic, c[j].z * ic, c[j].w * ic); }
    sca = xa * (1.0f / 127.0f); scc = xc * (1.0f / 127.0f);
    if (lane == 0) { *hsa = sca; *hsc = scc; }
}
__device__ __forceinline__ void load_t(f32x4 (&v)[4], const GAS bf16* hr, const GAS bf16* mr, int lane) {
#pragma unroll
    for (int j = 0; j < 4; ++j) { const v2u h = *(const GAS v2u*)(hr + 4 * lane + 256 * j); const v2u w = *(const GAS v2u*)(mr + 4 * lane + 256 * j);
        v[j].x = bflo(h.x) * ALPHA + bflo(w.x); v[j].y = bfhi(h.x) * ALPHA + bfhi(w.x); v[j].z = bflo(h.y) * ALPHA + bflo(w.y); v[j].w = bfhi(h.y) * ALPHA + bfhi(w.y); }
}
__device__ __forceinline__ void load_raw(v2u (&hr)[4], v2u (&mr)[4], const GAS bf16* hp, const GAS bf16* mp, int lane) {
#pragma unroll
    for (int j = 0; j < 4; ++j) { hr[j] = *(const GAS v2u*)(hp + 4 * lane + 256 * j); mr[j] = *(const GAS v2u*)(mp + 4 * lane + 256 * j); }
}
__device__ __forceinline__ void load_raw_q(v2u (&hr)[4], v2u (&mr)[4], const GAS signed char* hqp, const GAS float* hsp, const GAS bf16* mp, int lane) {
#pragma unroll
    for (int j = 0; j < 4; ++j) { hr[j].x = *(const GAS unsigned*)(hqp + 4 * lane + 256 * j); hr[j].y = 0u; mr[j] = *(const GAS v2u*)(mp + 4 * lane + 256 * j); }
    hr[0].y = __float_as_uint(*hsp);
}
__device__ __forceinline__ void cvt_t_q(f32x4 (&v)[4], const v2u (&hr)[4], const v2u (&mr)[4]) {
    const float sa = __uint_as_float(hr[0].y) * ALPHA;
#pragma unroll
    for (int j = 0; j < 4; ++j) { const int w = (int)hr[j].x;
        v[j].x = (float)((w << 24) >> 24) * sa + bflo(mr[j].x); v[j].y = (float)((w << 16) >> 24) * sa + bfhi(mr[j].x); v[j].z = (float)((w << 8) >> 24) * sa + bflo(mr[j].y); v[j].w = (float)(w >> 24) * sa + bfhi(mr[j].y); }
}
__device__ __forceinline__ void cvt_t(f32x4 (&v)[4], const v2u (&hr)[4], const v2u (&mr)[4]) {
#pragma unroll
    for (int j = 0; j < 4; ++j) { v[j].x = bflo(hr[j].x) * ALPHA + bflo(mr[j].x); v[j].y = bfhi(hr[j].x) * ALPHA + bfhi(mr[j].x); v[j].z = bflo(hr[j].y) * ALPHA + bflo(mr[j].y); v[j].w = bfhi(hr[j].y) * ALPHA + bfhi(mr[j].y); }
}
__device__ __forceinline__ void store_row_b(const f32x4 (&v)[4], GAS bf16* orow, int lane) {
#pragma unroll
    for (int j = 0; j < 4; ++j) { v2u w; w.x = pk2(v[j].x, v[j].y); w.y = pk2(v[j].z, v[j].w); *(GAS v2u*)(orow + 4 * lane + 256 * j) = w; }
}
__device__ __forceinline__ void store_row_f(const f32x4 (&v)[4], float* orow, int lane) {
#pragma unroll
    for (int j = 0; j < 4; ++j) *(GAS f32x4*)(orow + 4 * lane + 256 * j) = v[j];
}
struct PanelSrc { const GAS float* W; const GAS float* W2; int N; signed char* WT; gu32* cmax; int p; int mode; int fp8; };
__device__ __forceinline__ PanelSrc p0_panel_src(Frame& F, int it) {
    constexpr int P_IN = (NPROJ + 31) / 32 + 8, P_GU = 2048 / 32, P_DN = D / 32, PAN_LAYER = P_IN + NEXP * P_GU + NEXP * P_DN;
    const int l = it / PAN_LAYER; int r = it % PAN_LAYER; PanelSrc s; s.W2 = inp(F, 4) + (size_t)l * GLR_RANK * 256;
    if (r < P_IN) { s.W = inp(F, 3) + (size_t)l * D * NPROJ; s.N = NPROJ; s.WT = (signed char*)w_in_t(F, l); s.cmax = F.ctl + CW_CMAX_IN + l * NPROJ_PAD; s.fp8 = 0;
        if (r < P_IN - 8) { s.p = r; s.mode = 2; } else { s.p = r - (P_IN - 8); s.mode = 3; } }
    else if (r < P_IN + NEXP * P_GU) { r -= P_IN; const int e = r / P_GU; s.W = inp(F, 15) + ((size_t)l * NEXP + e) * D * 2048; s.N = 2048; s.WT = (signed char*)w_gu_t(F, l) + (size_t)e * 2048 * D; s.cmax = F.ctl + CW_CMAX_GU + (l * NEXP + e) * 2048; s.p = r % P_GU; s.mode = 1; s.fp8 = 0; }
    else { r -= P_IN + NEXP * P_GU; const int e = r / P_DN; s.W = inp(F, 17) + ((size_t)l * NEXP + e) * DFF * D; s.N = D; s.WT = (signed char*)w_dn_t(F, l) + (size_t)e * D * DFF; s.cmax = F.ctl + CW_CMAX_DN + (l * NEXP + e) * D; s.p = r % P_DN; s.mode = 0; s.fp8 = 1; }
    return s;
}
__device__ __forceinline__ void p0_panel_load(Frame& F, const PanelSrc& s, float (&rg)[64]) {
    const int lane = F.lane, wave = F.wave, n0 = 32 * s.p; const bool nok = (n0 + (lane & 31)) < s.N;
    if (s.mode == 3) {
        float wg[GLR_RANK];
#pragma unroll
        for (int r = 0; r < GLR_RANK; ++r) wg[r] = s.W2[r * 256 + n0 + (lane & 31)];
#pragma unroll
        for (int i = 0; i < 64; ++i) { const int k = 2 * (8 * i + wave) + (lane >> 5); const GAS f32x4* zr = (const GAS f32x4*)(s.W + (size_t)k * s.N + SRC_GLR); float a = 0.f;
#pragma unroll
            for (int q = 0; q < 4; ++q) { const f32x4 z = zr[q]; a += z.x * wg[4 * q] + z.y * wg[4 * q + 1] + z.z * wg[4 * q + 2] + z.w * wg[4 * q + 3]; }
            rg[i] = a; }
        return; }
#pragma unroll
    for (int i = 0; i < 64; ++i) { const int k = 2 * (8 * i + wave) + (lane >> 5); rg[i] = nok ? s.W[(size_t)k * s.N + n0 + (lane & 31)] : 0.f; }
}
__device__ __forceinline__ void p0_panels(Frame& F) {
    constexpr int P_IN = (NPROJ + 31) / 32 + 8, P_GU = 2048 / 32, P_DN = D / 32, PAN_LAYER = P_IN + NEXP * P_GU + NEXP * P_DN, NPAN = DEPTH * PAN_LAYER;
    LAS float* pan = (LAS float*)F.lds; LAS float* pmx = (LAS float*)(F.lds + TOK_OFF);
    const int tid = F.tid, lane = F.lane, wave = F.wave;
    int it = F.vcu; if (it >= NPAN) return;
    float rg[64]; PanelSrc cur = p0_panel_src(F, it); p0_panel_load(F, cur, rg);
    for (;;) {
#pragma unroll
        for (int i = 0; i < 64; ++i) { const int k = 2 * (8 * i + wave) + (lane >> 5); pan[k * 32 + (lane & 31)] = rg[i]; }
        lds_barrier();
        const int itn = it + F.G; const bool more = itn < NPAN; PanelSrc nxt = cur; if (more) { nxt = p0_panel_src(F, itn); p0_panel_load(F, nxt, rg); }
        const int n = tid & 31, ks = tid >> 5;
        float mx = 0.f;
#pragma unroll 8
        for (int i = 0; i < 64; ++i) mx = fmaxf(mx, fabsf(pan[(64 * ks + i) * 32 + n]));
        pmx[ks * 32 + n] = mx;
        lds_barrier();
        float cm = 0.f;
#pragma unroll
        for (int q = 0; q < 16; ++q) cm = fmaxf(cm, pmx[q * 32 + n]);
        const float inv = cm > 0.f ? (cur.fp8 ? pg8::WDN_SC : 127.0f) / cm : 0.f;
        const int ns = 32 * cur.p + n; int nd = ns; bool okc = ns < cur.N;
        if (cur.mode == 1) { const int half = ns >> 10, cc = ns & 1023; nd = (cc >> 7) * 256 + half * 128 + (cc & 127); }
        else if (cur.mode == 2) { nd = ns < SRC_GLR ? ns : ns + (C_GOG - SRC_GLR - GLR_RANK); okc = okc && !(ns >= SRC_GLR && ns < SRC_GLR + GLR_RANK); }
        else if (cur.mode == 3) { nd = C_GLG + ns; okc = ns < 256; }
        if (okc) {
            if (ks == 0) cur.cmax[nd] = __float_as_uint(cm);
            GAS v4u* dst = (GAS v4u*)(cur.WT + (size_t)nd * 1024 + 64 * ks);
#pragma unroll 1
            for (int g4 = 0; g4 < 4; ++g4) { unsigned w[4];
#pragma unroll
            for (int gg = 0; gg < 4; ++gg) { const int g = 4 * g4 + gg; const int kb = (64 * ks + 4 * g) * 32 + n;
                const float x0 = pan[kb] * inv, x1 = pan[kb + 32] * inv, x2 = pan[kb + 64] * inv, x3 = pan[kb + 96] * inv;
                if (cur.fp8) { int v = __builtin_amdgcn_cvt_pk_fp8_f32(x0, x1, 0, false); v = __builtin_amdgcn_cvt_pk_fp8_f32(x2, x3, v, true); w[gg] = (unsigned)v; }
                else w[gg] = pack_i8x4(x0, x1, x2, x3); }
            dst[g4] = (v4u){w[0], w[1], w[2], w[3]}; } }
        lds_barrier();
        if (!more) break;
        it = itn; cur = nxt;
    }
    __syncthreads();
}
__device__ __forceinline__ void p0_prologue(Frame& F) {
    p0_panels(F);
    LAS float* scr = (LAS float*)(F.lds + F.wave * 16384);
    const int gw = F.vcu * NWAVES + F.wave, NGW = F.G * NWAVES;
    constexpr int I_OUT = (D / 64) * (D / 32);
    for (int it = gw; it < DEPTH * I_OUT; it += NGW) { const int l = it / I_OUT, r = it % I_OUT; p0_transpose_item<0>(inp(F, 10) + (size_t)l * D * D, D, D, w_out_t(F, l), scr, r, F.lane); }
    GAS signed char* HQ = (GAS signed char*)(F.ws + WS_HB); GAS float* HS = (GAS float*)(F.ws + WS_HS);
    for (int m = gw; m < M; m += NGW) { f32x4 v[4]; const GAS float* xr = inp(F, 0) + (size_t)m * D;
#pragma unroll
        for (int j = 0; j < 4; ++j) v[j] = *(const GAS f32x4*)(xr + 4 * F.lane + 256 * j);
        ln_row(v, inp(F, 1), inp(F, 2), F.lane); store_row_q(v, HQ + (size_t)m * D, HS + m, F.lane); }
}

__device__ __forceinline__ float sigmoidf_(float x) { return __builtin_amdgcn_rcpf(1.0f + __expf(-x)); }
__device__ __forceinline__ float siluf_(float x) { return x * sigmoidf_(x); }
typedef short s16x4 __attribute__((ext_vector_type(4)));
typedef short v4i16_t __attribute__((ext_vector_type(4)));
typedef short bf16x8_t __attribute__((ext_vector_type(8)));
__device__ __forceinline__ s16x4 tr4(const LAS unsigned char* p) { return __builtin_bit_cast(s16x4, __builtin_amdgcn_ds_read_tr16_b64_v4i16((LAS v4i16_t*)p)); }
__device__ __forceinline__ bf16x8_t cat8(s16x4 a, s16x4 b) { return __builtin_shufflevector(a, b, 0, 1, 2, 3, 4, 5, 6, 7); }
constexpr int RAWP = 136;
constexpr int SC_QRAW = 0, SC_KRAW = 8704, SC_ZRAW = TOK_OFF  , SC_VRAW = 24576, SC_QI = 43008, SC_KI = 53248, SC_QS = 63488, SC_KS = 73728, SC_ST = 83968, SC_SEG = 120832, SC_EGL = 122880, SC_GN = 123136, SC_W = 123648, SC_BG = 127744, SC_XS = 128000, SC_XF = 128512;
constexpr int IMGP = 160, STP = 144;
template <int DV, bool GLA>
__device__ __forceinline__ void scan_chunked(Frame& F, int l, int b, int hd) {
    constexpr int NVT = DV / 16, VP = DV * 2 + 32, NOWN = NVT / 4, NVL = DV / 64;
    LAS unsigned char* L = F.lds;
    const bf16* proj = (const bf16*)(F.ws + WS_PROJ); bf16* Y = (bf16*)(F.ws + WS_Y);
    const int qc = GLA ? C_GQ + hd * 64 : C_HQ + hd * 64, kc = GLA ? C_GK + hd * 64 : C_HF + hd * 64, vc = GLA ? C_GV + hd * 128 : C_HI + hd * 64,
              ogc = GLA ? C_GOG + hd * 128 : C_HOG + hd * 64, yc = GLA ? hd * 128 : 512 + hd * 64;
    const int tid = F.tid, lane = F.lane, wave = F.wave;
    const int d = 8 * wave + (lane & 7), seg = lane >> 3;
    const int li = lane & 15, q4 = lane >> 4, lrow = (lane & 15) >> 2, lcol = 4 * (lane & 3);
    const size_t rowbase = (size_t)b * SEQ;
    float lb = 0.f;
    __syncthreads();
    if (GLA) {
        if (tid < 64) *(LAS float*)(L + SC_BG + tid * 4) = inp(F, 5)[l * 256 + hd * 64 + tid];
    } else if (l > 0) { const float r0 = inp(F, 7)[hd * 64 + d], r1 = inp(F, 7)[256 + hd * 64 + d]; lb = 1.0f / (1.0f + __expf(r0 - r1)); }
    const GAS float* gn = GLA ? inp(F, 6) + l * 128 : inp(F, 8) + l * 64;
    __syncthreads();
    if (tid < DV) *(LAS float*)(L + SC_GN + tid * 4) = gn[tid];
    for (int i = tid; i < DV * STP / 16; i += 512) *(LAS v4u*)(L + SC_ST + i * 16) = (v4u){0u, 0u, 0u, 0u};
    v4u rq, rk, rz, rv[NVL];
    auto issue = [&](int c) {
        const size_t r0 = rowbase + (size_t)c * 64;
        { const int row = tid >> 3, ch = tid & 7; const bf16* p = proj + (r0 + row) * NPROJ_PAD; rq = *(const GAS v4u*)(p + qc + 8 * ch); rk = *(const GAS v4u*)(p + kc + 8 * ch); }
        if (GLA) { const int row = tid >> 3, ch = tid & 7; rz = *(const GAS v4u*)(proj + (r0 + row) * NPROJ_PAD + C_GLG + hd * 64 + 8 * ch); }
#pragma unroll
        for (int j = 0; j < NVL; ++j) { const int idx = tid + 512 * j, row = idx / (DV / 8), ch = idx % (DV / 8); rv[j] = *(const GAS v4u*)(proj + (r0 + row) * NPROJ_PAD + vc + 8 * ch); }
    };
    auto commit_qkz = [&]() {
        { const int row = tid >> 3, ch = tid & 7; const int o = row * RAWP + ch * 16;
            *(LAS v2u*)(L + SC_QRAW + o) = (v2u){rq.x, rq.y}; *(LAS v2u*)(L + SC_QRAW + o + 8) = (v2u){rq.z, rq.w};
            *(LAS v2u*)(L + SC_KRAW + o) = (v2u){rk.x, rk.y}; *(LAS v2u*)(L + SC_KRAW + o + 8) = (v2u){rk.z, rk.w};
            if (GLA) { *(LAS v2u*)(L + SC_ZRAW + o) = (v2u){rz.x, rz.y}; *(LAS v2u*)(L + SC_ZRAW + o + 8) = (v2u){rz.z, rz.w}; } }
    };
    auto commit_v = [&]() {
#pragma unroll
        for (int j = 0; j < NVL; ++j) { const int idx = tid + 512 * j, row = idx / (DV / 8), ch = idx % (DV / 8); *(LAS v4u*)(L + SC_VRAW + row * VP + ch * 16) = rv[j]; }
    };
    issue(0); commit_qkz(); commit_v();
    f32x4 S[4];
#pragma unroll
    for (int dt = 0; dt < 4; ++dt) S[dt] = (f32x4){0.f, 0.f, 0.f, 0.f};
    if (tid < 8) *(LAS int*)(L + SC_XF + tid * 4) = 0;
    __syncthreads();
#pragma unroll 1
    for (int c = 0; c < SEQ / 64; ++c) {
        const int t0 = c * 64;
        if (c + 1 < SEQ / 64) issue(c + 1);
        float cs[8], kv[8];
        {
            float run = 0.f; float bg = 0.f;
            if (GLA) bg = *(const LAS float*)(L + SC_BG + d * 4);
#pragma unroll
            for (int e = 0; e < 8; ++e) { const int T = 8 * seg + e; float g;
                if (GLA) { const float lg = bf2f(*(const LAS unsigned short*)(L + SC_ZRAW + T * RAWP + d * 2)) + bg;
                    g = (fminf(lg, 0.f) - __logf(1.0f + __expf(-fabsf(lg)))) * (1.0f / 16.0f);
                    kv[e] = bf2f(*(const LAS unsigned short*)(L + SC_KRAW + T * RAWP + d * 2)); }
                else { const float z = bf2f(*(const LAS unsigned short*)(L + SC_KRAW + T * RAWP + d * 2)); const float f = lb + (1.0f - lb) * sigmoidf_(z); g = __logf(f); kv[e] = 1.0f - f; }
                run += g; cs[e] = run; }
            *(LAS float*)(L + SC_SEG + (seg * 64 + d) * 4) = run;
        }
        LDS_WAIT(); asm volatile("" ::: "memory");
        {
            float pre = 0.f, rd = 0.f, gl = 0.f;
#pragma unroll
            for (int s2 = 0; s2 < 8; ++s2) { const float v = *(const LAS float*)(L + SC_SEG + (s2 * 64 + d) * 4); if (s2 < seg) pre += v; if (s2 < 4) rd += v; gl += v; }
            const float er = __expf(rd), eglr = __expf(gl - rd);
            float qi[8], ki[8], qs[8], ks[8]; unsigned short qr[8];
#pragma unroll
            for (int e = 0; e < 8; ++e) qr[e] = *(const LAS unsigned short*)(L + SC_QRAW + (8 * seg + e) * RAWP + d * 2);
#pragma unroll
            for (int e = 0; e < 8; ++e) { const float gc = pre + cs[e]; const float E1 = __expf(gc - rd), E2 = __expf(rd - gc);
                float qv = bf2f(qr[e]); qv = GLA ? qv * 0.125f : siluf_(qv);
                qi[e] = qv * E1; qs[e] = qi[e] * er; ki[e] = kv[e] * E2; ks[e] = ki[e] * eglr; }
            v4u w;
            w.x = pk2(qi[0], qi[1]); w.y = pk2(qi[2], qi[3]); w.z = pk2(qi[4], qi[5]); w.w = pk2(qi[6], qi[7]); *(LAS v4u*)(L + SC_QI + d * IMGP + seg * 16) = w;
            w.x = pk2(ki[0], ki[1]); w.y = pk2(ki[2], ki[3]); w.z = pk2(ki[4], ki[5]); w.w = pk2(ki[6], ki[7]); *(LAS v4u*)(L + SC_KI + d * IMGP + seg * 16) = w;
            w.x = pk2(qs[0], qs[1]); w.y = pk2(qs[2], qs[3]); w.z = pk2(qs[4], qs[5]); w.w = pk2(qs[6], qs[7]); *(LAS v4u*)(L + SC_QS + d * IMGP + seg * 16) = w;
            w.x = pk2(ks[0], ks[1]); w.y = pk2(ks[2], ks[3]); w.z = pk2(ks[4], ks[5]); w.w = pk2(ks[6], ks[7]); *(LAS v4u*)(L + SC_KS + d * IMGP + seg * 16) = w;
            if (seg == 0) *(LAS float*)(L + SC_EGL + d * 4) = __expf(gl);
        }
        lds_barrier();
        const LAS unsigned char* STc = L + SC_ST + (c & 1) * (DV * STP);
        LAS unsigned char* STn = L + SC_ST + ((c + 1) & 1) * (DV * STP);
        {
            constexpr int NH = NVT / 2;
            const int it = wave & 3, hh = wave >> 2, I0 = 16 * it, V0 = hh * NH; const size_t row_i = rowbase + t0 + I0 + li;
            v2u ogr[NH];
#pragma unroll
            for (int vt = 0; vt < NH; ++vt) ogr[vt] = *(const GAS v2u*)(proj + row_i * NPROJ_PAD + ogc + 16 * (V0 + vt) + 4 * q4);
            f32x4 pt[4]; s16x4 sf[2][2];
#pragma unroll
            for (int jt = 0; jt < 4; ++jt) pt[jt] = (f32x4){0.f, 0.f, 0.f, 0.f};
#pragma unroll
            for (int ks = 0; ks < 2; ++ks) { const int R0 = 32 * ks + 8 * q4 + lrow; s16x4 kf[4][2], qf[2];
#pragma unroll
                for (int jt = 0; jt < 4; ++jt) { kf[jt][0] = tr4(L + SC_KI + R0 * IMGP + (16 * jt + lcol) * 2); kf[jt][1] = tr4(L + SC_KI + (R0 + 4) * IMGP + (16 * jt + lcol) * 2); }
                qf[0] = tr4(L + SC_QI + R0 * IMGP + (I0 + lcol) * 2); qf[1] = tr4(L + SC_QI + (R0 + 4) * IMGP + (I0 + lcol) * 2);
                sf[ks][0] = tr4(L + SC_QS + R0 * IMGP + (I0 + lcol) * 2); sf[ks][1] = tr4(L + SC_QS + (R0 + 4) * IMGP + (I0 + lcol) * 2);
#pragma unroll
                for (int jt = 0; jt < 4; ++jt) pt[jt] = __builtin_amdgcn_mfma_f32_16x16x32_bf16(cat8(kf[jt][0], kf[jt][1]), cat8(qf[0], qf[1]), pt[jt], 0, 0, 0); }
#pragma unroll
            for (int jt = 0; jt < 4; ++jt)
#pragma unroll
                for (int r = 0; r < 4; ++r) pt[jt][r] = (16 * jt + 4 * q4 + r <= I0 + li) ? pt[jt][r] : 0.f;
            bf16x8_t pb[2], qb[2];
#pragma unroll
            for (int s2 = 0; s2 < 2; ++s2) { v4u w; w.x = pk2(pt[2 * s2][0], pt[2 * s2][1]); w.y = pk2(pt[2 * s2][2], pt[2 * s2][3]); w.z = pk2(pt[2 * s2 + 1][0], pt[2 * s2 + 1][1]); w.w = pk2(pt[2 * s2 + 1][2], pt[2 * s2 + 1][3]);
                pb[s2] = __builtin_bit_cast(bf16x8_t, w); qb[s2] = cat8(sf[s2][0], sf[s2][1]); }
            f32x4 o[NH]; float ss = 0.f;
#pragma unroll
            for (int vp = 0; vp < NH; vp += 2) {
                s16x4 vf[2][2][2]; bf16x8_t stf[2][2];
#pragma unroll
                for (int x = 0; x < 2; ++x)
#pragma unroll
                    for (int s2 = 0; s2 < 2; ++s2) { const int R0 = 32 * s2 + 4 * q4 + lrow;
                        vf[x][s2][0] = tr4(L + SC_VRAW + R0 * VP + (16 * (V0 + vp + x) + lcol) * 2); vf[x][s2][1] = tr4(L + SC_VRAW + (R0 + 16) * VP + (16 * (V0 + vp + x) + lcol) * 2);
                        stf[x][s2] = *(const LAS bf16x8_t*)(STc + (16 * (V0 + vp + x) + li) * STP + (32 * s2 + 8 * q4) * 2); }
#pragma unroll
                for (int x = 0; x < 2; ++x) { f32x4 acc = (f32x4){0.f, 0.f, 0.f, 0.f};
#pragma unroll
                    for (int s2 = 0; s2 < 2; ++s2) acc = __builtin_amdgcn_mfma_f32_16x16x32_bf16(cat8(vf[x][s2][0], vf[x][s2][1]), pb[s2], acc, 0, 0, 0);
#pragma unroll
                    for (int s2 = 0; s2 < 2; ++s2) acc = __builtin_amdgcn_mfma_f32_16x16x32_bf16(stf[x][s2], qb[s2], acc, 0, 0, 0);
                    o[vp + x] = acc; ss += (acc[0] * acc[0] + acc[1] * acc[1]) + (acc[2] * acc[2] + acc[3] * acc[3]); } }
            ss += __shfl_xor(ss, 16); ss += __shfl_xor(ss, 32);
            if (q4 == 0) *(LAS float*)(L + SC_XS + (wave * 16 + li) * 4) = ss;
            LDS_WAIT(); asm volatile("" ::: "memory");
            if (lane == 0) *(volatile LAS int*)(L + SC_XF + wave * 4) = c + 1;
            if (wave < NVT) { const int vt = wave;
                bf16x8_t bk[4][2]; float eg[4];
#pragma unroll
                for (int dt = 0; dt < 4; ++dt) { eg[dt] = *(const LAS float*)(L + SC_EGL + (16 * dt + li) * 4);
#pragma unroll
                    for (int s2 = 0; s2 < 2; ++s2) bk[dt][s2] = *(const LAS bf16x8_t*)(L + SC_KS + (16 * dt + li) * IMGP + (32 * s2 + 8 * q4) * 2); }
                s16x4 vg[2][2];
#pragma unroll
                for (int s2 = 0; s2 < 2; ++s2) { const int R0 = 32 * s2 + 8 * q4 + lrow;
                    vg[s2][0] = tr4(L + SC_VRAW + R0 * VP + (16 * vt + lcol) * 2); vg[s2][1] = tr4(L + SC_VRAW + (R0 + 4) * VP + (16 * vt + lcol) * 2); }
#pragma unroll
                for (int dt = 0; dt < 4; ++dt) { f32x4 acc = S[dt] * eg[dt];
#pragma unroll
                    for (int s2 = 0; s2 < 2; ++s2) acc = __builtin_amdgcn_mfma_f32_16x16x32_bf16(cat8(vg[s2][0], vg[s2][1]), bk[dt][s2], acc, 0, 0, 0);
                    S[dt] = acc; }
#pragma unroll
                for (int dt = 0; dt < 4; ++dt)
#pragma unroll
                    for (int r = 0; r < 4; r += 2) { const unsigned w = pk2(S[dt][r], S[dt][r + 1]);
                        *(LAS unsigned short*)(STn + (16 * vt + 4 * q4 + r) * STP + (16 * dt + li) * 2) = (unsigned short)(w & 0xffffu);
                        *(LAS unsigned short*)(STn + (16 * vt + 4 * q4 + r + 1) * STP + (16 * dt + li) * 2) = (unsigned short)(w >> 16); } }
            { const int pw = wave ^ 4; int sp = 0;
                while (*(volatile LAS int*)(L + SC_XF + pw * 4) != c + 1) { __builtin_amdgcn_s_sleep(1); if (++sp > (1 << 20)) break; }
                asm volatile("" ::: "memory");
                ss += *(volatile LAS float*)(L + SC_XS + (pw * 16 + li) * 4); }
            const float rn = __builtin_amdgcn_rsqf(ss * (1.0f / DV) + RMS_EPS);
#pragma unroll
            for (int vp = 0; vp < NH; vp += 2) { v2u w2[2];
#pragma unroll
                for (int x = 0; x < 2; ++x) { const int vt = vp + x; const f32x4 g4 = *(const LAS f32x4*)(L + SC_GN + (16 * (V0 + vt) + 4 * q4) * 4);
                    const float y0 = o[vt][0] * rn * g4[0] * siluf_(bflo(ogr[vt].x)), y1 = o[vt][1] * rn * g4[1] * siluf_(bfhi(ogr[vt].x)),
                                y2 = o[vt][2] * rn * g4[2] * siluf_(bflo(ogr[vt].y)), y3 = o[vt][3] * rn * g4[3] * siluf_(bfhi(ogr[vt].y));
                    w2[x].x = pk2(y0, y1); w2[x].y = pk2(y2, y3); }
                auto r0 = __builtin_amdgcn_permlane16_swap(w2[0].x, w2[1].x, false, false); auto r1 = __builtin_amdgcn_permlane16_swap(w2[0].y, w2[1].y, false, false);
                const int odd = q4 & 1;
                *(GAS v4u*)(Y + row_i * D + yc + 16 * (V0 + vp + odd) + 4 * (q4 - odd)) = (v4u){(unsigned)r0[0], (unsigned)r1[0], (unsigned)r0[1], (unsigned)r1[1]}; }
        }
        if (c + 1 < SEQ / 64) commit_qkz();
        lds_barrier();
        if (c + 1 < SEQ / 64) commit_v();
    }
}
__device__ __forceinline__ void p2_scan(Frame& F, int l) {
    for (int it = F.vcu; it < BATCH * 8; it += F.G) { const int b = it >> 3, u = it & 7;
        if (u < 4) scan_chunked<128, true>(F, l, b, u); else scan_chunked<64, false>(F, l, b, u - 4); }
    const bf16* proj = (const bf16*)(F.ws + WS_PROJ); bf16* Y = (bf16*)(F.ws + WS_Y);
    const GAS float* cw = inp(F, 9) + (size_t)l * 3 * 256;
    const bool even = (F.G == BATCH * 8); const bool isg = (F.vcu & 7) < 4; const int gi = (F.vcu >> 3) * 4 + ((F.vcu & 7) & 3);
    const long NCH = (long)M * 32 / 512, c_lo = even ? (isg ? 0 : CONV_GLA_CHUNKS) : 0, c_hi = even ? (isg ? CONV_GLA_CHUNKS : NCH) : NCH;
    const long cstart = (c_lo + (even ? gi : F.vcu)) * 512 + F.tid, cstride = (even ? 128L : (long)F.G) * 512;
    {
        const int ch = (int)(cstart & 31) * 8; const long cend = c_hi * 512;
        float cwr[3][8];
#pragma unroll
        for (int j = 0; j < 3; ++j)
#pragma unroll
            for (int q = 0; q < 8; ++q) cwr[j][q] = cw[256 * j + ch + q];
        v4u ccn[3], hhn[3], bbn;
        auto ld = [&](long idx) { const int row = (int)(idx >> 5), t = row & (SEQ - 1);
#pragma unroll
            for (int j = 0; j < 3; ++j) { const int dt = 2 - j; const int rr = (t - dt >= 0) ? row - dt : row;
                ccn[j] = *(const GAS v4u*)(proj + (size_t)rr * NPROJ_PAD + C_CC + ch); hhn[j] = *(const GAS v4u*)(proj + (size_t)rr * NPROJ_PAD + C_CH + ch); }
            bbn = *(const GAS v4u*)(proj + (size_t)row * NPROJ_PAD + C_CB + ch); };
        if (cstart < cend) ld(cstart);
#pragma unroll 1
        for (long idx = cstart; idx < cend; idx += cstride) { const int row = (int)(idx >> 5), t = row & (SEQ - 1);
            v4u cc[3], hh[3]; const v4u bb = bbn;
#pragma unroll
            for (int j = 0; j < 3; ++j) { cc[j] = ccn[j]; hh[j] = hhn[j]; }
            if (idx + cstride < cend) ld(idx + cstride);
            float o[8];
#pragma unroll
            for (int q = 0; q < 8; ++q) { float cv = 0.f;
#pragma unroll
                for (int j = 0; j < 3; ++j) { const unsigned cw2 = cc[j][q >> 1], hw2 = hh[j][q >> 1]; const float u = (q & 1) ? bfhi(cw2) * bfhi(hw2) : bflo(cw2) * bflo(hw2); cv += (t - (2 - j) >= 0) ? cwr[j][q] * u : 0.f; }
                const float bq = (q & 1) ? bfhi(bb[q >> 1]) : bflo(bb[q >> 1]); o[q] = bq * cv; }
            v4u w; w.x = pk2(o[0], o[1]); w.y = pk2(o[2], o[3]); w.z = pk2(o[4], o[5]); w.w = pk2(o[6], o[7]);
            *(GAS v4u*)(Y + (size_t)row * D + 768 + ch) = w; }
    }
}

constexpr int R_PITCH = 2064;
constexpr int R_HI = 0, R_LO = 16 * R_PITCH, R_PART = 2 * 16 * R_PITCH;
static_assert(R_PART + 8 * 16 * 32 * 4 <= RING_BYTES, "router LDS map");
__device__ __forceinline__ void p4_ln_router(Frame& F, int l) {
    LAS unsigned char* L = F.lds;
    LAS int* tokE = (LAS int*)(L + TOK_OFF); LAS int* tokP = tokE + 1024; LAS float* tokG = (LAS float*)(tokP + 1024);
    LAS int* lcnt = (LAS int*)(tokG + 1024); LAS int* gbase = lcnt + 32; LAS float* tokS = (LAS float*)(gbase + 32);
    const GAS float* Wr = inp(F, 13) + (size_t)l * D * NEXP; const GAS float* br = inp(F, 14) + l * NEXP;
    const GAS float* lng = inp(F, 11) + l * D; const GAS float* lnb = inp(F, 12) + l * D;
    GAS signed char* HQ = (GAS signed char*)(F.ws + WS_HB); GAS float* HS = (GAS float*)(F.ws + WS_HS);
    GAS int* slot_dst = (GAS int*)(F.ws + WS_SLOT); GAS float* slot_gate = (GAS float*)(F.ws + WS_SLOT + 8 * MiB); GAS float* slot_hs = (GAS float*)(F.ws + WS_SLOT + 16 * MiB);
    GAS bf16* MIX = (GAS bf16*)(F.ws + WS_MIX);
    gu32* gcnt = F.ctl + CW_CNT + l * 64;
    const int tid = F.tid, lane = F.lane, wave = F.wave, li = lane & 15, q4 = lane >> 4;
    bf16x8_t whi[4][2], wlo[4][2];
#pragma unroll
    for (int ks = 0; ks < 4; ++ks)
#pragma unroll
        for (int nt = 0; nt < 2; ++nt) { float w[8], wl[8];
#pragma unroll
            for (int j = 0; j < 8; ++j) { w[j] = Wr[(size_t)(128 * wave + 32 * ks + 8 * q4 + j) * NEXP + 16 * nt + li]; wl[j] = w[j] - bf2f((unsigned short)f2bf(w[j])); }
            v4u a, b; a.x = pk2(w[0], w[1]); a.y = pk2(w[2], w[3]); a.z = pk2(w[4], w[5]); a.w = pk2(w[6], w[7]); b.x = pk2(wl[0], wl[1]); b.y = pk2(wl[2], wl[3]); b.z = pk2(wl[4], wl[5]); b.w = pk2(wl[6], wl[7]);
            whi[ks][nt] = __builtin_bit_cast(bf16x8_t, a); wlo[ks][nt] = __builtin_bit_cast(bf16x8_t, b); }
    __syncthreads();
    for (int tb = F.vcu; tb < M / 256; tb += F.G) {
        if (tid < 32) lcnt[tid] = 0;
        v2u hA[2][4], mA[2][4], hB[2][4], mB[2][4];
#pragma unroll
        for (int r = 0; r < 2; ++r) { const size_t m0 = (size_t)(tb * 256 + 2 * wave + r); load_raw_q(hA[r], mA[r], HQ + m0 * D, HS + m0, MIX + m0 * D, lane);
            load_raw_q(hB[r], mB[r], HQ + (m0 + 16) * D, HS + m0 + 16, MIX + (m0 + 16) * D, lane); }
#pragma unroll 1
        for (int g2 = 0; g2 < 16; g2 += 2) {
#pragma unroll
          for (int par = 0; par < 2; ++par) { const int g = g2 + par;
            f32x4 v[2][4];
#pragma unroll
            for (int r = 0; r < 2; ++r) { if (par == 0) cvt_t_q(v[r], hA[r], mA[r]); else cvt_t_q(v[r], hB[r], mB[r]); }
            if (g + 2 < 16) {
#pragma unroll
                for (int r = 0; r < 2; ++r) { const size_t m0 = (size_t)(tb * 256 + (g + 2) * 16 + 2 * wave + r);
                    if (par == 0) load_raw_q(hA[r], mA[r], HQ + m0 * D, HS + m0, MIX + m0 * D, lane); else load_raw_q(hB[r], mB[r], HQ + m0 * D, HS + m0, MIX + m0 * D, lane); } }
            { const size_t m0 = (size_t)tb * 256 + g * 16 + 2 * wave; float sc0, sc1;
                ln_row2(v[0], v[1], lng, lnb, lane); store_row_q2(v[0], v[1], HQ + m0 * D, HQ + (m0 + 1) * D, HS + m0, HS + m0 + 1, lane, sc0, sc1);
                if (lane == 0) { tokS[g * 16 + 2 * wave] = sc0; tokS[g * 16 + 2 * wave + 1] = sc1; } }
#pragma unroll
            for (int r = 0; r < 2; ++r) { const int trow = 2 * wave + r;
#pragma unroll
                for (int j = 0; j < 4; ++j) { const f32x4 x = v[r][j]; v2u hi; hi.x = pk2(x.x, x.y); hi.y = pk2(x.z, x.w);
                    v2u lo; lo.x = pk2(x.x - bflo(hi.x), x.y - bfhi(hi.x)); lo.y = pk2(x.z - bflo(hi.y), x.w - bfhi(hi.y));
                    *(LAS v2u*)(L + R_HI + trow * R_PITCH + (4 * lane + 256 * j) * 2) = hi; *(LAS v2u*)(L + R_LO + trow * R_PITCH + (4 * lane + 256 * j) * 2) = lo; } }
            lds_barrier();
            f32x4 acc[2] = {(f32x4){0.f, 0.f, 0.f, 0.f}, (f32x4){0.f, 0.f, 0.f, 0.f}}, acb[2] = {(f32x4){0.f, 0.f, 0.f, 0.f}, (f32x4){0.f, 0.f, 0.f, 0.f}}, acc3[2] = {(f32x4){0.f, 0.f, 0.f, 0.f}, (f32x4){0.f, 0.f, 0.f, 0.f}};
            bf16x8_t ah[4], al[4];
#pragma unroll
            for (int ks = 0; ks < 4; ++ks) { ah[ks] = *(const LAS bf16x8_t*)(L + R_HI + li * R_PITCH + (128 * wave + 32 * ks + 8 * q4) * 2); al[ks] = *(const LAS bf16x8_t*)(L + R_LO + li * R_PITCH + (128 * wave + 32 * ks + 8 * q4) * 2); }
#pragma unroll
            for (int ks = 0; ks < 4; ++ks)
#pragma unroll
                for (int nt = 0; nt < 2; ++nt) { acc[nt] = __builtin_amdgcn_mfma_f32_16x16x32_bf16(ah[ks], whi[ks][nt], acc[nt], 0, 0, 0);
                    acb[nt] = __builtin_amdgcn_mfma_f32_16x16x32_bf16(al[ks], whi[ks][nt], acb[nt], 0, 0, 0); acc3[nt] = __builtin_amdgcn_mfma_f32_16x16x32_bf16(ah[ks], wlo[ks][nt], acc3[nt], 0, 0, 0); }
#pragma unroll
            for (int nt = 0; nt < 2; ++nt) acc[nt] = acc[nt] + (acb[nt] + acc3[nt]);
#pragma unroll
            for (int nt = 0; nt < 2; ++nt)
#pragma unroll
                for (int r = 0; r < 4; ++r) *(LAS float*)(L + R_PART + ((wave * 16 + 4 * q4 + r) * 32 + 16 * nt + li) * 4) = acc[nt][r];
            lds_barrier();
            { const int row = tid >> 5, e = tid & 31; float val = br[e]; float pw[8];
#pragma unroll
                for (int w = 0; w < 8; ++w) pw[w] = *(const LAS float*)(L + R_PART + ((w * 16 + row) * 32 + e) * 4);
                val += ((pw[0] + pw[1]) + (pw[2] + pw[3])) + ((pw[4] + pw[5]) + (pw[6] + pw[7]));
                float tv[4]; int te[4];
#pragma unroll
                for (int k = 0; k < 4; ++k) { float mx = val;
                    mx = fmaxf(mx, dpp_mv<0xb1, 0xf>(mx)); mx = fmaxf(mx, dpp_mv<0x4e, 0xf>(mx)); mx = fmaxf(mx, dpp_mv<0x124, 0xf>(mx)); mx = fmaxf(mx, dpp_mv<0x128, 0xf>(mx)); mx = xmax16(mx);
                    const unsigned long long bal = __ballot(val == mx); const unsigned hb32 = (unsigned)(bal >> (lane & 32)); const int es = __builtin_ctz(hb32);
                    tv[k] = mx; te[k] = es; if (e == es) val = -3.0e38f; }
                const float e1 = __expf(tv[1] - tv[0]), e2 = __expf(tv[2] - tv[0]), e3 = __expf(tv[3] - tv[0]); const float inv = __builtin_amdgcn_rcpf(1.0f + e1 + e2 + e3);
                if (e < 4) { const int ek = e == 0 ? te[0] : e == 1 ? te[1] : e == 2 ? te[2] : te[3];
                    const float gk = (e == 0 ? 1.0f : e == 1 ? e1 : e == 2 ? e2 : e3) * inv; const int tl = g * 16 + row;
                    const int lp = __hip_atomic_fetch_add(lcnt + ek, 1, __ATOMIC_RELAXED, __HIP_MEMORY_SCOPE_WORKGROUP);
                    tokE[tl * 4 + e] = ek; tokP[tl * 4 + e] = lp; tokG[tl * 4 + e] = gk; } }
          }
        }
        __syncthreads();
        if (tid < 32) gbase[tid] = (int)__hip_atomic_fetch_add(gcnt + tid, (unsigned)lcnt[tid], RLX_AGENT);
        __syncthreads();
        for (int i = tid; i < 1024; i += 512) { const int e = tokE[i], pos = gbase[e] + tokP[i]; const size_t si = (size_t)e * CAP + pos;
            slot_dst[si] = (tb * 256 + (i >> 2)) * 4 + (i & 3); slot_gate[si] = tokG[i]; slot_hs[si] = tokS[i >> 2]; }
        __syncthreads();
    }
}

__device__ __forceinline__ int build_units(Frame& F, int l, int NT) {
    LAS int* list = (LAS int*)(F.lds + ULIST_OFF);
    gu32* gcnt = F.ctl + CW_CNT + l * 64;
    LAS int* cnts = (LAS int*)(F.lds + TOK_OFF);
    __syncthreads();
    if (F.tid < NEXP) cnts[F.tid] = (int)__hip_atomic_load(gcnt + F.tid, RLX_AGENT);
    __syncthreads();
    int nU = 0;
    {
        int tot = 0; for (int e = 0; e < NEXP; ++e) { const int c = cnts[e]; tot += ((c + 255) >> 8) * NT; }
        nU = (tot > F.vcu) ? (tot - F.vcu + F.G - 1) / F.G : 0; if (nU > 64) nU = 64;
        if (F.tid < nU) { const int q = F.tid * F.G + F.vcu; int base = 0, blk0 = 0, e = 0, c = 0, nb = 0;
            for (e = 0; e < NEXP; ++e) { c = cnts[e]; nb = (c + 255) >> 8; if (q < base + nb * NT) break; base += nb * NT; blk0 += nb; }
            const int lq = q - base, rg = lq / (8 * NT), l2 = lq % (8 * NT), gsz = (nb - 8 * rg) < 8 ? (nb - 8 * rg) : 8, pn = l2 / gsz, rb = 8 * rg + l2 % gsz;
            list[F.tid * 8 + 0] = blk0 + rb; list[F.tid * 8 + 1] = e * NT + pn; list[F.tid * 8 + 2] = e; list[F.tid * 8 + 3] = rb; list[F.tid * 8 + 4] = c; }
    }
    __syncthreads();
    return nU;
}


__device__ __forceinline__ void p7_combine(Frame& F, int l) {
    const int gw = F.vcu * NWAVES + F.wave, NGW = F.G * NWAVES, lane = F.lane;
    const GAS unsigned char* y4 = (const GAS unsigned char*)(F.ws + WS_Y4);
    GAS signed char* HQ = (GAS signed char*)(F.ws + WS_HB); GAS float* HS = (GAS float*)(F.ws + WS_HS);
    const GAS float* g2 = inp(F, 19) + l * D; const GAS float* b2 = inp(F, 20) + l * D;
    const bool lastl = (l == DEPTH - 1);
    for (int m = 4 * gw; m < M; m += 4 * NGW) {
        f32x4 v[4][4]; unsigned hv[4][4]; float hsa[4]; unsigned yv[4][4][4];
#pragma unroll
        for (int r = 0; r < 4; ++r) {
#pragma unroll
            for (int j = 0; j < 4; ++j) hv[r][j] = *(const GAS unsigned*)(HQ + (size_t)(m + r) * D + 4 * lane + 256 * j);
            hsa[r] = HS[m + r] * ALPHA;
#pragma unroll
            for (int k = 0; k < 4; ++k)
#pragma unroll
                for (int j = 0; j < 4; ++j) yv[r][k][j] = *(const GAS unsigned*)(y4 + ((size_t)(m + r) * 4 + k) * D + 4 * lane + 256 * j); }
#pragma unroll
        for (int r = 0; r < 4; ++r) {
#pragma unroll
            for (int j = 0; j < 4; ++j) { const int hw = (int)hv[r][j]; f32x4 a; a.x = (float)((hw << 24) >> 24) * hsa[r]; a.y = (float)((hw << 16) >> 24) * hsa[r]; a.z = (float)((hw << 8) >> 24) * hsa[r]; a.w = (float)(hw >> 24) * hsa[r];
                f32x4 ys = (f32x4){0.f, 0.f, 0.f, 0.f};
#pragma unroll
                for (int k = 0; k < 4; ++k) { const int w = (int)yv[r][k][j]; ys.x += __builtin_amdgcn_cvt_f32_fp8(w, 0); ys.y += __builtin_amdgcn_cvt_f32_fp8(w, 1); ys.z += __builtin_amdgcn_cvt_f32_fp8(w, 2); ys.w += __builtin_amdgcn_cvt_f32_fp8(w, 3); }
                v[r][j] = a + ys * (1.0f / 16.0f); }
            ln_row(v[r], g2, b2, lane);
            if (lastl) store_row_f(v[r], F.H + (size_t)(m + r) * D, lane);
            else store_row_q(v[r], HQ + (size_t)(m + r) * D, HS + m + r, lane); }
    }
}

struct Args { const float* in[21]; float* out; unsigned char* ws; int ph_lo, ph_hi; };
constexpr int N_PHASES = 2 + 7 * DEPTH;
__global__ void __launch_bounds__(NWAVES * 64, 2) fwd_kernel(Args args) {
    extern __shared__ __attribute__((aligned(16))) unsigned char lds[];
    Frame F;
    F.lds = (LAS unsigned char*)lds;
    F.MISC = (volatile LAS unsigned*)(F.lds + MISC_OFF);
    F.tid = threadIdx.x; F.lane = F.tid & 63; F.wave = __builtin_amdgcn_readfirstlane(F.tid >> 6);
    F.G = gridDim.x; { const int bx = blockIdx.x; F.vcu = (F.G % 8 == 0) ? (bx % 8) * (F.G / 8) + bx / 8 : bx; }
    F.ws = args.ws; F.ctl = (gu32*)(args.ws + WS_CTL); F.H = args.out;
    F.ka = (const __attribute__((address_space(4))) unsigned char*)__builtin_amdgcn_kernarg_segment_ptr();
    for (int u = F.tid; u < 64; u += NWAVES * 64) ((LAS unsigned*)(F.lds + MISC_OFF))[u] = 0u;
    __syncthreads();
#if MK_ONE_LAUNCH
    XcdBarrier bar = xcd_barrier_post((unsigned*)(F.ctl + CW_BAR), F.MISC + 8);
#define GRID_BAR() xcd_barrier(bar, F.tid == 0)
#else
#define GRID_BAR() do {} while (0)
#endif
#if MK_ONE_LAUNCH
    constexpr int lo = 0, hi = N_PHASES;
#else
    const int lo = args.ph_lo, hi = args.ph_hi;
#endif
#ifndef PH_MASK
#define PH_MASK 0xff
#endif
#define IN(k) (lo <= (k) && (k) < hi)
#define PHON(j) ((PH_MASK >> (j)) & 1)
#ifndef P7_DRY
#define P7_DRY 0
#endif
#ifndef P4_DRY
#define P4_DRY 0
#endif
#ifndef REP_MASK
#define REP_MASK 0
#endif
#define NREP(j) (((REP_MASK >> (j)) & 1) ? 2 : 1)
#define OPQ(p) do { unsigned _lo = (unsigned)(uintptr_t)(p), _hi = (unsigned)((uintptr_t)(p) >> 32); asm volatile("" : "+v"(_lo), "+v"(_hi)); _lo = __builtin_amdgcn_readfirstlane(_lo); _hi = __builtin_amdgcn_readfirstlane(_hi); \
        (p) = (decltype(p))(((uintptr_t)_hi << 32) | _lo); } while (0)
#define REFRESH() do { OPQ(F.ka); OPQ(F.ws); OPQ(F.H); F.lane = (int)__builtin_amdgcn_mbcnt_hi(~0u, __builtin_amdgcn_mbcnt_lo(~0u, 0u)); F.tid = (F.wave << 6) | F.lane; asm volatile("" : "+v"(F.tid)); F.lane = F.tid & 63; F.ctl = (gu32*)(F.ws + WS_CTL); F.lds = (LAS unsigned char*)lds; } while (0)
    if (PHON(0) && IN(1)) for (int rep = 0; rep < NREP(0); ++rep) { REFRESH(); p0_prologue(F); GRID_BAR(); }
#pragma unroll 1
    for (int l = 0; l < DEPTH; ++l) {
        const int pb = 2 + 7 * l;
        if (PHON(1) && IN(pb + 0)) for (int rep = 0; rep < NREP(1); ++rep) { REFRESH();
            pg8::Gemm g{(const bf16*)(F.ws + WS_HB), w_in_t(F, l), D}; pg8::StaticOrder S; S.init(M, NPROJ_PAD, F.G, (int)blockIdx.x);
            pg8::EpiProj E{(bf16*)(F.ws + WS_PROJ), NPROJ_PAD, (const GAS float*)(F.ws + WS_HS), (const GAS unsigned*)(F.ctl + CW_CMAX_IN + l * NPROJ_PAD)};
            pg8::gemm_phase<pg8::EpiProj, pg8::StaticOrder, false, 1>(F.lds, (LAS unsigned*)(F.lds + TOK_OFF), g, S, E, F.tid);
            GRID_BAR();
        }
        if (PHON(2) && IN(pb + 1)) for (int rep = 0; rep < NREP(2); ++rep) { REFRESH(); p2_scan(F, l); GRID_BAR(); }
        if (PHON(3) && IN(pb + 2)) { REFRESH();
            pg8::Gemm g{(const bf16*)(F.ws + WS_Y), w_out_t(F, l), D}; pg8::StaticOrder S; S.init(M, D, F.G, (int)blockIdx.x);
            pg8::EpiMix E{(bf16*)(F.ws + WS_MIX)};
            pg8::gemm_phase<pg8::EpiMix, pg8::StaticOrder, false, 0>(F.lds, (LAS unsigned*)(F.lds + TOK_OFF), g, S, E, F.tid);
            GRID_BAR();
        }
                if (PHON(4) && IN(pb + 3)) { REFRESH(); p4_ln_router(F, l); GRID_BAR(); }
        if (PHON(5) && IN(pb + 4)) for (int rep = 0; rep < NREP(5); ++rep) { REFRESH();
            const int nU = build_units(F, l, 8);
            pg8::Gemm g{(const bf16*)(F.ws + WS_HB), w_gu_t(F, l), D};
            pg8::ListOrder S{(const LAS int*)(F.lds + ULIST_OFF), nU, (const GAS int*)(F.ws + WS_SLOT), CAP, 1024u};
            pg8::EpiSwiglu E{(unsigned char*)(F.ws + WS_ACT), inp(F, 16) + (size_t)l * NEXP * 2048, (const GAS float*)(F.ws + WS_SLOT + 16 * MiB), (const GAS unsigned*)(F.ctl + CW_CMAX_GU + l * NEXP * 2048), CAP};
            pg8::gemm_phase<pg8::EpiSwiglu, pg8::ListOrder, true, 1>(F.lds, (LAS unsigned*)(F.lds + TOK_OFF), g, S, E, F.tid);
            GRID_BAR();
        }
        if (PHON(6) && IN(pb + 5)) for (int rep = 0; rep < NREP(6); ++rep) { REFRESH();
            const int nU = build_units(F, l, 4);
            pg8::Gemm g{(const bf16*)(F.ws + WS_ACT), w_dn_t(F, l), DFF};
            pg8::ListOrder S{(const LAS int*)(F.lds + ULIST_OFF), nU, (const GAS int*)(F.ws + WS_SLOT), CAP, 1024u};
            pg8::EpiDown E{(bf16*)(F.ws + WS_Y4), M * 4, inp(F, 18) + (size_t)l * NEXP * D, (const GAS int*)(F.ws + WS_SLOT), (const GAS float*)(F.ws + WS_SLOT + 8 * MiB), (const GAS unsigned*)(F.ctl + CW_CMAX_DN + l * NEXP * D), CAP};
            pg8::gemm_phase<pg8::EpiDown, pg8::ListOrder, false, 2>(F.lds, (LAS unsigned*)(F.lds + TOK_OFF), g, S, E, F.tid);
            GRID_BAR();
        }
        if (PHON(7) && IN(pb + 6)) { REFRESH(); p7_combine(F, l); if (l + 1 < DEPTH) GRID_BAR(); }
    }
#undef IN
}

extern "C" void kernel_launch(void* const* d_in, const int* in_sizes, int n_in, void* d_out, int out_size, void* d_ws, size_t ws_size, hipStream_t stream) {
    static int grid = 0;
    if (grid == 0) {
        if (n_in != 21 || in_sizes[0] != M * D || out_size != M * D || ws_size < WS_END) { fprintf(stderr, "kernel_launch: unexpected shapes (n_in %d, in0 %d, out %d, ws %zu)\n", n_in, n_in > 0 ? in_sizes[0] : -1, out_size, ws_size); grid = -1; return; }
        int dev = 0, cus = 0, per_cu = 0;
        if (hipGetDevice(&dev) != hipSuccess || hipDeviceGetAttribute(&cus, hipDeviceAttributeMultiprocessorCount, dev) != hipSuccess) { grid = -1; return; }
        if (hipFuncSetAttribute((const void*)fwd_kernel, hipFuncAttributeMaxDynamicSharedMemorySize, LDS_BYTES) != hipSuccess) { fprintf(stderr, "kernel_launch: hipFuncSetAttribute failed\n"); grid = -1; return; }
        if (hipOccupancyMaxActiveBlocksPerMultiprocessor(&per_cu, (const void*)fwd_kernel, NWAVES * 64, LDS_BYTES) != hipSuccess || per_cu < 1) fprintf(stderr, "kernel_launch: occupancy query says %d\n", per_cu);
        (void)hipGetLastError();
        grid = cus;
    }
    if (grid < 0) return;
    if (hipMemsetAsync((char*)d_ws + WS_CTL, 0, 128 * 1024, stream) != hipSuccess) return;
    Args a{};
    for (int i = 0; i < 21; ++i) a.in[i] = (const float*)d_in[i];
    a.out = (float*)d_out; a.ws = (unsigned char*)d_ws;
#if MK_ONE_LAUNCH
    a.ph_lo = 0; a.ph_hi = N_PHASES;
    hipLaunchKernelGGL(fwd_kernel, dim3(grid), dim3(NWAVES * 64), LDS_BYTES, stream, a);
#else
    for (int p = 0; p < N_PHASES; ++p) { a.ph_lo = p; a.ph_hi = p + 1; hipLaunchKernelGGL(fwd_kernel, dim3(grid), dim3(NWAVES * 64), LDS_BYTES, stream, a); }
#endif
}
```
